# Optimizing an MI355X kernel written in HIP

```python
import jax, jax.numpy as jnp
from jax import lax
import numpy as np

D_MODEL = 2048
BATCH = 4
SEQ = 4096
DEPTH = 2

N_A_LAYERS = DEPTH // 2
N_B_LAYERS = DEPTH - N_A_LAYERS
N_MEM = 256
MEM_HEADS = 4
MEM_HEAD_DIM = D_MODEL // 16
MEM_WIDTH = MEM_HEADS * MEM_HEAD_DIM
BRANCH_WIDTH = D_MODEL - MEM_WIDTH
GLA_HEADS = 4
GLA_DV = BRANCH_WIDTH // GLA_HEADS
GLA_DK = GLA_DV // 2
GLA_GATE_RANK = 16
GLA_GATE_NORM = 16.0
GLA_CHUNK = 64
MLA_HEADS = 12
MLA_V_DIM = BRANCH_WIDTH // MLA_HEADS
MLA_NOPE_DIM = 128
MLA_ROPE_DIM = 64
MLA_Q_RANK = D_MODEL // 4
MLA_KV_RANK = D_MODEL // 4
ROPE_THETA = 10000.0
Q_BLOCK = 128
EPS = 1e-6

A_SPLITS = [GLA_HEADS * GLA_DK, GLA_HEADS * GLA_DK, BRANCH_WIDTH, GLA_GATE_RANK,
            BRANCH_WIDTH, MEM_WIDTH, MEM_WIDTH]
A_IN_WIDTH = sum(A_SPLITS)
B_SPLITS = [MLA_Q_RANK, BRANCH_WIDTH, MEM_WIDTH, MEM_WIDTH]
B_IN_WIDTH = sum(B_SPLITS)
MLA_QK_DIM = MLA_NOPE_DIM + MLA_ROPE_DIM

kernel_name = 'yoco_gla_mla_memory_hybrid'


def _split(t, sizes):
    return jnp.split(t, list(np.cumsum(sizes)[:-1]), axis=-1)


def rmsnorm(x, g):
    xf = x.astype(jnp.float32)
    xf = xf * lax.rsqrt(jnp.mean(xf * xf, axis=-1, keepdims=True) + EPS)
    return (xf * g.astype(jnp.float32)).astype(x.dtype)


def rope(x, positions):
    r = x.shape[-1]
    freqs = ROPE_THETA ** (-jnp.arange(0, r, 2, dtype=jnp.float32) / r)
    ang = positions.astype(jnp.float32)[..., None] * freqs
    ang = ang.reshape(ang.shape[:2] + (1,) * (x.ndim - 3) + (r // 2,))
    cos, sin = jnp.cos(ang), jnp.sin(ang)
    xf = x.astype(jnp.float32)
    x1, x2 = xf[..., : r // 2], xf[..., r // 2:]
    return jnp.concatenate([x1 * cos - x2 * sin, x2 * cos + x1 * sin], axis=-1).astype(x.dtype)


def mem_attend(q, mem, mem_g, w_kv):
    b_, s_ = q.shape[:2]
    m_ = mem.shape[1]
    k, v = jnp.split(rmsnorm(mem, mem_g) @ w_kv, 2, axis=-1)
    k = k.reshape(b_, m_, MEM_HEADS, MEM_HEAD_DIM)
    v = v.reshape(b_, m_, MEM_HEADS, MEM_HEAD_DIM)
    qh = q.reshape(b_, s_, MEM_HEADS, MEM_HEAD_DIM)
    s = jnp.einsum('bshd,bmhd->bhsm', qh, k).astype(jnp.float32) * MEM_HEAD_DIM ** -0.5
    p = jax.nn.softmax(s, axis=-1).astype(v.dtype)
    return jnp.einsum('bhsm,bmhd->bshd', p, v).reshape(b_, s_, MEM_WIDTH)


def gla_chunked(q, k, v, log_a):
    b_, s_ = q.shape[:2]
    nc = s_ // GLA_CHUNK

    def to_chunks(t):
        return t.astype(jnp.float32).reshape(b_, nc, GLA_CHUNK, GLA_HEADS, t.shape[-1]).transpose(1, 0, 3, 2, 4)

    qc, kc, vc, gc = to_chunks(q), to_chunks(k), to_chunks(v), to_chunks(log_a)
    causal = jnp.tril(jnp.ones((GLA_CHUNK, GLA_CHUNK), dtype=bool))[None, None, :, :, None]

    def step(state, inp):
        qi, ki, vi, gi = inp
        cum = jnp.cumsum(gi, axis=2)
        o_inter = jnp.einsum('bhck,bhkv->bhcv', qi * jnp.exp(cum), state)
        diff = cum[:, :, :, None, :] - cum[:, :, None, :, :]
        decay = jnp.where(causal, jnp.exp(jnp.where(causal, diff, 0.0)), 0.0)
        attn = jnp.einsum('bhtk,bhsk,bhtsk->bhts', qi, ki, decay)
        o_intra = jnp.einsum('bhts,bhsv->bhtv', attn, vi)
        last = cum[:, :, -1:, :]
        state = jnp.exp(last[:, :, 0, :])[..., None] * state + jnp.einsum(
            'bhsk,bhsv->bhkv', ki * jnp.exp(last - cum), vi)
        return state, o_inter + o_intra

    s0 = jnp.zeros((b_, GLA_HEADS, GLA_DK, GLA_DV), jnp.float32)
    _, o = lax.scan(step, s0, (qc, kc, vc, gc))
    return o.transpose(1, 0, 3, 2, 4).reshape(b_, s_, GLA_HEADS, GLA_DV).astype(v.dtype)


def layer_a(x, mem, pre_g, w_in, w_g2, b_g, gla_g, mem_g, w_mem_kv, w_out, post_g):
    b_, s_ = x.shape[:2]
    h = rmsnorm(x, pre_g)
    q, k, v, g_lr, z, mq, mz = _split(h @ w_in, A_SPLITS)
    q = q.reshape(b_, s_, GLA_HEADS, GLA_DK) * GLA_DK ** -0.5
    k = k.reshape(b_, s_, GLA_HEADS, GLA_DK)
    v = v.reshape(b_, s_, GLA_HEADS, GLA_DV)
    log_a = jax.nn.log_sigmoid((g_lr @ w_g2 + b_g).astype(jnp.float32)) / GLA_GATE_NORM
    log_a = log_a.reshape(b_, s_, GLA_HEADS, GLA_DK)
    o = rmsnorm(gla_chunked(q, k, v, log_a), gla_g)
    gla_out = o.reshape(b_, s_, BRANCH_WIDTH) * jax.nn.silu(z)
    mem_out = mem_attend(mq, mem, mem_g, w_mem_kv) * jax.nn.silu(mz)
    y = jnp.concatenate([gla_out, mem_out], axis=-1) @ w_out
    return x + rmsnorm(y, post_g)


def shared_mla_kv(x, positions, kv_in_g, w_dkv, kv_g, w_uk, w_uv):
    b_, s_ = x.shape[:2]
    c, k_rope = _split(rmsnorm(x, kv_in_g) @ w_dkv, [MLA_KV_RANK, MLA_ROPE_DIM])
    c = rmsnorm(c, kv_g)
    k_nope = (c @ w_uk).reshape(b_, s_, MLA_HEADS, MLA_NOPE_DIM)
    v = (c @ w_uv).reshape(b_, s_, MLA_HEADS, MLA_V_DIM)
    k_rope = rope(k_rope, positions)
    return k_nope, k_rope, v


def mla_attention(q_nope, q_rope, k_nope, k_rope, v):
    b_, s_ = q_nope.shape[:2]
    nb = s_ // Q_BLOCK
    qn = q_nope.reshape(b_, nb, Q_BLOCK, MLA_HEADS, MLA_NOPE_DIM).transpose(1, 0, 3, 2, 4)
    qr = q_rope.reshape(b_, nb, Q_BLOCK, MLA_HEADS, MLA_ROPE_DIM).transpose(1, 0, 3, 2, 4)
    kpos = jnp.arange(s_)

    def block(args):
        qn_b, qr_b, start = args
        s = jnp.einsum('bhqd,bkhd->bhqk', qn_b, k_nope) + jnp.einsum('bhqr,bkr->bhqk', qr_b, k_rope)
        s = s.astype(jnp.float32) * MLA_QK_DIM ** -0.5
        qpos = start + jnp.arange(Q_BLOCK)
        s = jnp.where(kpos[None, :] <= qpos[:, None], s, -jnp.inf)
        p = jax.nn.softmax(s, axis=-1).astype(v.dtype)
        return jnp.einsum('bhqk,bkhd->bqhd', p, v)

    starts = jnp.arange(nb, dtype=jnp.int32) * Q_BLOCK
    o = lax.map(block, (qn, qr, starts))
    return o.transpose(1, 0, 2, 3, 4).reshape(b_, s_, MLA_HEADS, MLA_V_DIM)


def layer_b(x, mem, positions, k_nope, k_rope, v, pre_g, w_in, q_g, w_uq, mem_g, w_mem_kv, w_out, post_g):
    b_, s_ = x.shape[:2]
    h = rmsnorm(x, pre_g)
    cq, z, mq, mz = _split(h @ w_in, B_SPLITS)
    q = (rmsnorm(cq, q_g) @ w_uq).reshape(b_, s_, MLA_HEADS, MLA_QK_DIM)
    q_nope, q_rope = q[..., :MLA_NOPE_DIM], rope(q[..., MLA_NOPE_DIM:], positions)
    o = mla_attention(q_nope, q_rope, k_nope, k_rope, v)
    mla_out = o.reshape(b_, s_, BRANCH_WIDTH) * jax.nn.silu(z)
    mem_out = mem_attend(mq, mem, mem_g, w_mem_kv) * jax.nn.silu(mz)
    y = jnp.concatenate([mla_out, mem_out], axis=-1) @ w_out
    return x + rmsnorm(y, post_g)


def setup_inputs(seed: int = 0) -> dict:
    key = jax.random.key(seed)
    ks = jax.random.split(key, 32)
    f32 = jnp.float32

    def w(k, shape, fan_in):
        return jax.random.normal(k, shape, f32) * fan_in ** -0.5

    def gain(k, shape):
        return 1.0 + 0.05 * jax.random.normal(k, shape, f32)

    na, nbl = N_A_LAYERS, N_B_LAYERS
    return {
        'x': jax.random.normal(ks[0], (BATCH, SEQ, D_MODEL), f32),
        'mem': jax.random.normal(ks[1], (BATCH, N_MEM, D_MODEL), f32),
        'positions': (jax.random.randint(ks[2], (BATCH, 1), 0, 512, dtype=jnp.int32)
                      + jnp.arange(SEQ, dtype=jnp.int32)[None, :]),
        'a_pre_norm': gain(ks[3], (na, D_MODEL)),
        'a_w_in': w(ks[4], (na, D_MODEL, A_IN_WIDTH), D_MODEL),
        'a_w_g2': w(ks[5], (na, GLA_GATE_RANK, GLA_HEADS * GLA_DK), GLA_GATE_RANK),
        'a_b_g': 0.5 + 0.1 * jax.random.normal(ks[6], (na, GLA_HEADS * GLA_DK), f32),
        'a_gla_norm': gain(ks[7], (na, GLA_DV)),
        'a_mem_norm': gain(ks[8], (na, D_MODEL)),
        'a_w_mem_kv': w(ks[9], (na, D_MODEL, 2 * MEM_WIDTH), D_MODEL),
        'a_w_out': w(ks[10], (na, D_MODEL, D_MODEL), D_MODEL),
        'a_post_norm': gain(ks[11], (na, D_MODEL)),
        'kv_in_norm': gain(ks[12], (D_MODEL,)),
        'w_dkv': w(ks[13], (D_MODEL, MLA_KV_RANK + MLA_ROPE_DIM), D_MODEL),
        'kv_norm': gain(ks[14], (MLA_KV_RANK,)),
        'w_uk': w(ks[15], (MLA_KV_RANK, MLA_HEADS * MLA_NOPE_DIM), MLA_KV_RANK),
        'w_uv': w(ks[16], (MLA_KV_RANK, MLA_HEADS * MLA_V_DIM), MLA_KV_RANK),
        'b_pre_norm': gain(ks[17], (nbl, D_MODEL)),
        'b_w_in': w(ks[18], (nbl, D_MODEL, B_IN_WIDTH), D_MODEL),
        'b_q_norm': gain(ks[19], (nbl, MLA_Q_RANK)),
        'b_w_uq': w(ks[20], (nbl, MLA_Q_RANK, MLA_HEADS * MLA_QK_DIM), MLA_Q_RANK),
        'b_mem_norm': gain(ks[21], (nbl, D_MODEL)),
        'b_w_mem_kv': w(ks[22], (nbl, D_MODEL, 2 * MEM_WIDTH), D_MODEL),
        'b_w_out': w(ks[23], (nbl, D_MODEL, D_MODEL), D_MODEL),
        'b_post_norm': gain(ks[24], (nbl, D_MODEL)),
    }


def reference(x, mem, positions, a_pre_norm, a_w_in, a_w_g2, a_b_g, a_gla_norm, a_mem_norm,
              a_w_mem_kv, a_w_out, a_post_norm, kv_in_norm, w_dkv, kv_norm, w_uk, w_uv,
              b_pre_norm, b_w_in, b_q_norm, b_w_uq, b_mem_norm, b_w_mem_kv, b_w_out, b_post_norm):
    k_nope = k_rope = v_sh = None
    for i in range(DEPTH):
        if i < N_A_LAYERS:
            x = layer_a(x, mem, a_pre_norm[i], a_w_in[i], a_w_g2[i], a_b_g[i], a_gla_norm[i],
                        a_mem_norm[i], a_w_mem_kv[i], a_w_out[i], a_post_norm[i])
        else:
            j = i - N_A_LAYERS
            if j == 0:
                k_nope, k_rope, v_sh = shared_mla_kv(x, positions, kv_in_norm, w_dkv, kv_norm, w_uk, w_uv)
            x = layer_b(x, mem, positions, k_nope, k_rope, v_sh, b_pre_norm[j], b_w_in[j], b_q_norm[j],
                        b_w_uq[j], b_mem_norm[j], b_w_mem_kv[j], b_w_out[j], b_post_norm[j])
    return x
```

```cpp
#include <hip/hip_runtime.h>
#include <hip/hip_cooperative_groups.h>
#include <cstdio>
namespace cg = cooperative_groups;

#define DI __device__ __forceinline__
#define LAS __attribute__((address_space(3)))
typedef unsigned short bf16_t;
typedef short bf16x8 __attribute__((ext_vector_type(8)));
typedef float f32x4 __attribute__((ext_vector_type(4)));
typedef float f32x2 __attribute__((ext_vector_type(2)));
typedef float f32x16 __attribute__((ext_vector_type(16)));
typedef unsigned u32x4 __attribute__((ext_vector_type(4)));
typedef unsigned u32x2 __attribute__((ext_vector_type(2)));
typedef __bf16 bf16nx2 __attribute__((ext_vector_type(2)));

constexpr int T = 16384, DM = 2048, SEQ = 4096;
constexpr int NTHR = 512;
constexpr int NA = 4352;
constexpr int A_Q = 0, A_K = 768, A_Z = 1536, A_MQ = 3072, A_MZ = 3584, A_G = 4096;
constexpr int NBI = 3840;
constexpr int B_CQ = 0, B_Z = 512, B_MQ = 2048, B_MZ = 2560, B_C = 3072, B_KR = 3584;
constexpr float LOG2E = 1.4426950408889634f;
constexpr float EPS = 1e-6f;

constexpr size_t al256(size_t x) { return (x + 255) & ~(size_t)255; }
constexpr size_t O_CTL = 0;
constexpr size_t CTL_BYTES = 16384;
constexpr size_t O_WA_IN = CTL_BYTES;
constexpr size_t O_WA_V = O_WA_IN + (size_t)NA * 2048 * 2;
constexpr size_t O_WA_OUT = O_WA_V + (size_t)1536 * 2048 * 2;
constexpr size_t O_WMK_A = O_WA_OUT + (size_t)2048 * 2048 * 2;
constexpr size_t O_WMV_A = O_WMK_A + (size_t)512 * 2048 * 2;
constexpr size_t O_WMK_B = O_WMV_A + (size_t)512 * 2048 * 2;
constexpr size_t O_WMV_B = O_WMK_B + (size_t)512 * 2048 * 2;
constexpr size_t O_WB_IN = O_WMV_B + (size_t)512 * 2048 * 2;
constexpr size_t O_WUK = O_WB_IN + (size_t)NBI * 2048 * 2;
constexpr size_t O_WUV = O_WUK + (size_t)1536 * 512 * 2;
constexpr size_t O_WUQ = O_WUV + (size_t)1536 * 512 * 2;
constexpr size_t O_WB_OUT = O_WUQ + (size_t)2304 * 512 * 2;
constexpr size_t O_MEMN = O_WB_OUT + (size_t)2048 * 2048 * 2;
constexpr size_t O_MEMK_A = O_MEMN + (size_t)1024 * 2048 * 2;
constexpr size_t O_MEMVT_A = O_MEMK_A + (size_t)1024 * 512 * 2;
constexpr size_t O_MEMK_B = O_MEMVT_A + (size_t)1024 * 512 * 2;
constexpr size_t O_MEMVT_B = O_MEMK_B + (size_t)1024 * 512 * 2;
constexpr size_t O_COS = O_MEMVT_B + (size_t)1024 * 512 * 2;
constexpr size_t O_SIN = O_COS + (size_t)T * 32 * 4;
constexpr size_t O_DVEC = O_SIN + (size_t)T * 32 * 4;
constexpr size_t O_H = O_DVEC + (size_t)1024 * 192 * 4;
constexpr size_t O_PROJ = O_H + (size_t)T * 2048 * 2;
constexpr size_t O_VT = O_PROJ + (size_t)T * NA * 2;
constexpr size_t O_ST = O_VT + (size_t)1536 * T * 2;
constexpr size_t O_Q = O_ST;
constexpr size_t O_KF = O_ST + (size_t)T * 2304 * 2;
constexpr size_t O_CN = O_ST + (size_t)1024 * 73728 * 2;
constexpr size_t O_CQN = O_CN + (size_t)T * 512 * 2;
constexpr size_t WS_END = O_CQN + (size_t)T * 512 * 2;
static_assert(WS_END <= (size_t)536870912, "workspace");
static_assert((size_t)T * 2304 * 2 * 2 <= (size_t)1024 * 73728 * 2, "Q+K fit");

DI float bf2f(bf16_t b) { return __uint_as_float(((unsigned)b) << 16); }
DI float bflo(unsigned u) { return __uint_as_float(u << 16); }
DI float bfhi(unsigned u) { return __uint_as_float(u & 0xffff0000u); }
DI unsigned pk2(float lo, float hi) { f32x2 v = {lo, hi}; bf16nx2 r = __builtin_convertvector(v, bf16nx2); return __builtin_bit_cast(unsigned, r); }
DI bf16_t f2bf(float x) { return (bf16_t)(pk2(x, 0.f) & 0xffffu); }
DI f32x4 ldnt_f4(const float* p) { return __builtin_nontemporal_load((const f32x4*)p); }
DI u32x2 ldnt_u2(const void* p) { return __builtin_nontemporal_load((const u32x2*)p); }
DI u32x4 ldnt_u4(const void* p) { return __builtin_nontemporal_load((const u32x4*)p); }
DI void stnt_f4(float* p, f32x4 v) { __builtin_nontemporal_store(v, (f32x4*)p); }
DI void stnt_u2(void* p, u32x2 v) { __builtin_nontemporal_store(v, (u32x2*)p); }
DI float wave_sum(float v) {
#pragma unroll
    for (int o = 32; o >= 1; o >>= 1) v += __shfl_xor(v, o, 64);
    return v;
}
DI float silu(float z) { return z / (1.f + __expf(-z)); }
DI int tokperm16(int p) { const int g = (p >> 2) & 3; const int g2 = (g == 1) ? 2 : (g == 2 ? 1 : g); return (p & ~12) | (g2 << 2); }

typedef const __attribute__((address_space(4))) unsigned char* kargp_t;
struct Ctx {
    kargp_t ka; float* out; unsigned char* ws; LAS unsigned char* lds;
    DI const float* in(int i) const { return *(const float* const __attribute__((address_space(4)))*)(ka + 8 * i); }
};

struct ConvJob { const float* src; const float* src2; const float* gain; const float* gain2; bf16_t* dst; int ldsrc, ldsrc2, K, rows, kind; };
DI ConvJob conv_job(const Ctx& c, int j) {
    ConvJob J; J.src2 = nullptr; J.gain2 = nullptr; J.ldsrc2 = 0;
    unsigned char* ws = c.ws;
    switch (j) {
    case 0: J = ConvJob{c.in(4), nullptr, c.in(3), nullptr, (bf16_t*)(ws + O_WA_IN), 5648, 0, 2048, NA, 0}; break;
    case 1: J = ConvJob{c.in(4), nullptr, c.in(3), nullptr, (bf16_t*)(ws + O_WA_V), 5648, 0, 2048, 1536, 1}; break;
    case 2: J = ConvJob{c.in(10), nullptr, nullptr, nullptr, (bf16_t*)(ws + O_WA_OUT), 2048, 0, 2048, 2048, 2}; break;
    case 3: J = ConvJob{c.in(9), nullptr, c.in(8), nullptr, (bf16_t*)(ws + O_WMK_A), 1024, 0, 2048, 512, 2}; break;
    case 4: J = ConvJob{c.in(9) + 512, nullptr, c.in(8), nullptr, (bf16_t*)(ws + O_WMV_A), 1024, 0, 2048, 512, 2}; break;
    case 5: J = ConvJob{c.in(22), nullptr, c.in(21), nullptr, (bf16_t*)(ws + O_WMK_B), 1024, 0, 2048, 512, 2}; break;
    case 6: J = ConvJob{c.in(22) + 512, nullptr, c.in(21), nullptr, (bf16_t*)(ws + O_WMV_B), 1024, 0, 2048, 512, 2}; break;
    case 7: J = ConvJob{c.in(18), c.in(13), c.in(17), c.in(12), (bf16_t*)(ws + O_WB_IN), 3072, 576, 2048, NBI, 3}; break;
    case 8: J = ConvJob{c.in(15), nullptr, c.in(14), nullptr, (bf16_t*)(ws + O_WUK), 1536, 0, 512, 1536, 2}; break;
    case 9: J = ConvJob{c.in(16), nullptr, c.in(14), nullptr, (bf16_t*)(ws + O_WUV), 1536, 0, 512, 1536, 2}; break;
    case 10: J = ConvJob{c.in(20), nullptr, c.in(19), nullptr, (bf16_t*)(ws + O_WUQ), 2304, 0, 512, 2304, 4}; break;
    default: J = ConvJob{c.in(23), nullptr, nullptr, nullptr, (bf16_t*)(ws + O_WB_OUT), 2048, 0, 2048, 2048, 2}; break;
    }
    return J;
}
constexpr int N_CONV_JOBS = 12;
DI int conv_tiles(int j) {
    switch (j) {
    case 0: return (NA / 64) * 16; case 1: return 24 * 16; case 2: return 32 * 16;
    case 3: case 4: case 5: case 6: return 8 * 16;
    case 7: return (NBI / 64) * 16; case 8: case 9: return 24 * 4; case 10: return 36 * 4; default: return 32 * 16;
    }
}
DI void conv_map(int kind, int n, int& col, float& scale, int& which) {
    which = 0; scale = 1.f; col = n;
    if (kind == 0) {
        if (n < 768) { col = n; scale = 0.07216878364870322f; }
        else if (n < 1536) col = n;
        else if (n < 3072) col = 3088 + (n - 1536);
        else if (n < 3584) { col = 4624 + (n - 3072); scale = 0.08838834764831845f * LOG2E; }
        else if (n < 4096) col = 5136 + (n - 3584);
        else if (n < 4112) col = 3072 + (n - 4096);
        else col = -1;
    } else if (kind == 1) { col = 1536 + n; }
    else if (kind == 3) {
        if (n < 3072) { col = n; if (n >= 2048 && n < 2560) scale = 0.08838834764831845f * LOG2E; }
        else if (n < 3648) { col = n - 3072; which = 1; }
        else col = -1;
    } else if (kind == 4) {
        scale = 0.07216878364870322f * LOG2E;
        const int hd = n / 192, off = n % 192;
        if (off < 128) col = n;
        else { const int p = off - 128, g = p >> 3, e = p & 7; col = hd * 192 + 128 + (e < 4 ? 4 * g + e : 32 + 4 * g + (e - 4)); }
    }
}
DI void conv_tile(const Ctx& c, const ConvJob& J, int tile) {
    const int tid = threadIdx.x;
    const int ktiles = J.K / 128;
    const int n0 = (tile / ktiles) * 64, k0 = (tile % ktiles) * 128;
    LAS bf16_t* sm = (LAS bf16_t*)c.lds;
    const int nq = (tid & 15) * 4, kq = tid >> 4;
    int col, which; float scale; conv_map(J.kind, n0 + nq, col, scale, which);
    const float* src = which ? J.src2 : J.src; const int ld = which ? J.ldsrc2 : J.ldsrc; const float* gain = which ? J.gain2 : J.gain;
    f32x4 v[4];
#pragma unroll
    for (int i = 0; i < 4; ++i) { const int k = k0 + kq + 32 * i; v[i] = (col >= 0) ? ldnt_f4(src + (size_t)k * ld + col) : (f32x4){0.f, 0.f, 0.f, 0.f}; }
#pragma unroll
    for (int i = 0; i < 4; ++i) { const int k = k0 + kq + 32 * i; const float g = (gain ? gain[k] : 1.f) * scale;
#pragma unroll
        for (int e = 0; e < 4; ++e) sm[(nq + e) * 136 + kq + 32 * i] = f2bf(v[i][e] * g); }
    __syncthreads();
#pragma unroll
    for (int i = 0; i < 2; ++i) { const int id = tid + 512 * i, row = id >> 4, ck = id & 15;
        const u32x4 w = *(const LAS u32x4*)(sm + row * 136 + ck * 8);
        *(u32x4*)(J.dst + (size_t)(n0 + row) * J.K + k0 + ck * 8) = w; }
    __syncthreads();
}
DI void norm_rows_f32(const float* src, bf16_t* dst, int nrows) {
    const int lane = threadIdx.x & 63, wv = threadIdx.x >> 6;
    for (int r = blockIdx.x * 8 + wv; r < nrows; r += gridDim.x * 8) {
        const float* p = src + (size_t)r * 2048;
        f32x4 a[8]; float ss = 0.f;
#pragma unroll
        for (int i = 0; i < 8; ++i) { a[i] = ldnt_f4(p + 4 * lane + 256 * i); ss += a[i][0] * a[i][0] + a[i][1] * a[i][1] + a[i][2] * a[i][2] + a[i][3] * a[i][3]; }
        ss = wave_sum(ss); const float rr = rsqrtf(ss * (1.f / 2048.f) + EPS);
#pragma unroll
        for (int i = 0; i < 8; ++i) { u32x2 w; w[0] = pk2(a[i][0] * rr, a[i][1] * rr); w[1] = pk2(a[i][2] * rr, a[i][3] * rr);
            *(u32x2*)(dst + (size_t)r * 2048 + 4 * lane + 256 * i) = w; }
    }
}
DI bool conv_deferred(int j) { return j == 2 || j == 8 || j == 9 || j == 10 || j == 11; }
DI void conv_fill(const Ctx& c, int units, int j_lo, int j_hi) {
    const int G = gridDim.x, r = units % G;
    int nidle = (r == 0) ? G : G - r, me = (r == 0) ? (int)blockIdx.x : (int)blockIdx.x - r;
    if (me < 0) return;
    int base = 0;
    for (int j = j_lo; j <= j_hi; ++j) {
        if (!conv_deferred(j)) continue;
        const int nt = conv_tiles(j); const ConvJob J = conv_job(c, j);
        int first = me - (base % nidle); if (first < 0) first += nidle;
        for (int t = first; t < nt; t += nidle) conv_tile(c, J, t);
        base += nt;
    }
}
DI void phase0(const Ctx& c) {
    int base = 0;
    for (int j = 0; j < N_CONV_JOBS; ++j) {
        if (conv_deferred(j)) continue;
        const int nt = conv_tiles(j); const ConvJob J = conv_job(c, j);
        int first = (int)blockIdx.x - (base % (int)gridDim.x); if (first < 0) first += gridDim.x;
        for (int t = first; t < nt; t += gridDim.x) conv_tile(c, J, t);
        base += nt;
    }
    norm_rows_f32(c.in(0), (bf16_t*)(c.ws + O_H), T);
    norm_rows_f32(c.in(1), (bf16_t*)(c.ws + O_MEMN), 1024);
}

namespace pg8 {
constexpr int BM = 256, BK = 64, HALF = 128, HTB = HALF * BK * 2, STAGE_BYTES = 8 * HTB, NXCD = 8, WGM = 8;
DI int lds_byte(int r, int c) { const int st = (r >> 4) * 2 + (c >> 5), rr = r & 15, cc = c & 31, ob = rr * 64 + cc * 2; return st * 1024 + (ob ^ (((ob >> 9) & 1) << 5)); }
DI void stage_rc(int b, int& R, int& C) { const int st = b / 1024, sb = b % 1024, swz = sb ^ (((sb >> 9) & 1) << 5); R = (st >> 1) * 16 + swz / 64; C = (st & 1) * 32 + (swz % 64) / 2; }
DI int perm32(int rho) { const int n = rho >> 4, i = rho & 15; return 8 * (i >> 2) + 4 * n + (i & 3); }
DI int permT(int rho) { const int n = rho >> 4, i = rho & 15, fq = i >> 2, j = i & 3; return 16 * (fq >> 1) + 4 * ((fq & 1) + 2 * n) + j; }

struct Unit { int pm, pn, gid; };
struct GDesc { const bf16_t* A; const bf16_t* Bt; bf16_t* C; int nM, nN, ldc, mode; };

template <int PH> DI int n_gemms();
template <int PH> DI GDesc gdesc(unsigned char* ws, int gid);
template <int PH> struct PhK;

template <> struct PhK<1> { static constexpr int K = 2048; };
template <> DI int n_gemms<1>() { return 6; }
template <> DI GDesc gdesc<1>(unsigned char* ws, int gid) {
    switch (gid) {
    case 0: return GDesc{(const bf16_t*)(ws + O_H), (const bf16_t*)(ws + O_WA_IN), (bf16_t*)(ws + O_PROJ), 64, 17, NA, 0};
    case 1: return GDesc{(const bf16_t*)(ws + O_WA_V), (const bf16_t*)(ws + O_H), (bf16_t*)(ws + O_VT), 6, 64, T, 1 | 32};
    case 2: return GDesc{(const bf16_t*)(ws + O_MEMN), (const bf16_t*)(ws + O_WMK_A), (bf16_t*)(ws + O_MEMK_A), 4, 2, 512, 0};
    case 3: return GDesc{(const bf16_t*)(ws + O_WMV_A), (const bf16_t*)(ws + O_MEMN), (bf16_t*)(ws + O_MEMVT_A), 2, 4, 1024, 1};
    case 4: return GDesc{(const bf16_t*)(ws + O_MEMN), (const bf16_t*)(ws + O_WMK_B), (bf16_t*)(ws + O_MEMK_B), 4, 2, 512, 0};
    default: return GDesc{(const bf16_t*)(ws + O_WMV_B), (const bf16_t*)(ws + O_MEMN), (bf16_t*)(ws + O_MEMVT_B), 2, 4, 1024, 1};
    }
}
template <> struct PhK<3> { static constexpr int K = 2048; };
template <> DI int n_gemms<3>() { return 1; }
template <> DI GDesc gdesc<3>(unsigned char* ws, int) { return GDesc{(const bf16_t*)(ws + O_H), (const bf16_t*)(ws + O_WA_OUT), (bf16_t*)(ws + O_PROJ), 64, 8, 2048, 0}; }
template <> struct PhK<5> { static constexpr int K = 2048; };
template <> DI int n_gemms<5>() { return 1; }
template <> DI GDesc gdesc<5>(unsigned char* ws, int) { return GDesc{(const bf16_t*)(ws + O_H), (const bf16_t*)(ws + O_WB_IN), (bf16_t*)(ws + O_PROJ), 64, 15, NBI, 0}; }
template <> struct PhK<7> { static constexpr int K = 512; };
template <> DI int n_gemms<7>() { return 3; }
template <> DI GDesc gdesc<7>(unsigned char* ws, int gid) {
    switch (gid) {
    case 0: return GDesc{(const bf16_t*)(ws + O_CQN), (const bf16_t*)(ws + O_WUQ), (bf16_t*)(ws + O_Q), 64, 9, 2304, 4};
    case 1: return GDesc{(const bf16_t*)(ws + O_CN), (const bf16_t*)(ws + O_WUK), (bf16_t*)(ws + O_KF), 64, 6, 2304, 2};
    default: return GDesc{(const bf16_t*)(ws + O_WUV), (const bf16_t*)(ws + O_CN), (bf16_t*)(ws + O_VT), 6, 64, T, 1};
    }
}
template <> struct PhK<9> { static constexpr int K = 2048; };
template <> DI int n_gemms<9>() { return 1; }
template <> DI GDesc gdesc<9>(unsigned char* ws, int) { return GDesc{(const bf16_t*)(ws + O_H), (const bf16_t*)(ws + O_WB_OUT), (bf16_t*)(ws + O_ST), 64, 8, 2048, 0}; }

template <int PH> DI bool next_unit(unsigned char* ws, int i, int G, int c, Unit& u, GDesc& g) {
    long L = (long)i * G + c;
    const int ng = n_gemms<PH>();
    bool found = false;
#pragma unroll
    for (int gid = 0; gid < 6; ++gid) {
        if (gid < ng && !found) {
            const GDesc d = gdesc<PH>(ws, gid); const int nwg = d.nM * d.nN;
            if (L < nwg) {
                int wgid = (int)L; const int nM = d.nM, nN = d.nN;
                { const int q = nwg / NXCD, r = nwg % NXCD, xcd = wgid % NXCD, off = wgid / NXCD; wgid = (xcd < r ? xcd * (q + 1) : r * (q + 1) + (xcd - r) * q) + off; }
                const int nig = WGM * nN, grp = wgid / nig, fm = grp * WGM, gsz = (nM - fm) < WGM ? (nM - fm) : WGM;
                u.pm = fm + ((wgid % nig) % gsz); u.pn = (wgid % nig) / gsz; u.gid = gid; g = d; found = true;
            } else L -= nwg;
        }
    }
    return found;
}

DI void epilogue(const f32x4 (&acc)[2][2][4][2], const Unit& u, const GDesc& g, const float* cosT, const float* sinT, int wr, int wc, int fr, int fq) {
    const int row0 = u.pm * BM + wr * 64 + fr;
#pragma unroll
    for (int bj = 0; bj < 2; ++bj) {
        const int c8 = u.pn * BM + bj * HALF + wc * 32 + 8 * fq;
        int dcol = c8; bool rope = false; int fg = 0;
        if (g.mode & 2) dcol = (c8 >> 7) * 192 + (c8 & 127);
        if (g.mode & 4) { const int off = c8 % 192; if (off >= 128) { rope = true; fg = (off - 128) >> 3; } }
#pragma unroll
        for (int ai = 0; ai < 2; ++ai)
#pragma unroll
            for (int m = 0; m < 4; ++m) {
                const int row = row0 + ai * HALF + m * 16;
                f32x4 v0 = acc[ai][bj][m][0], v1 = acc[ai][bj][m][1];
                if (rope) {
                    const f32x4 cs = *(const f32x4*)(cosT + (size_t)row * 32 + 4 * fg), sn = *(const f32x4*)(sinT + (size_t)row * 32 + 4 * fg);
                    const f32x4 a = v0 * cs - v1 * sn, b = v1 * cs + v0 * sn; v0 = a; v1 = b;
                }
                u32x4 w; w[0] = pk2(v0[0], v0[1]); w[1] = pk2(v0[2], v0[3]); w[2] = pk2(v1[0], v1[1]); w[3] = pk2(v1[2], v1[3]);
                if (g.mode & 32) {
                    const int p = c8 & 63;
                    *(u32x4*)(g.C + ((((size_t)(row >> 5) * (T / 64) + (c8 >> 6)) * 4 + (p >> 4)) * 64 + (row & 31) + 32 * ((p >> 3) & 1)) * 8) = w;
                } else *(u32x4*)(g.C + (size_t)row * g.ldc + dcol) = w;
            }
    }
}

template <int PH>
DI void gemm_phase(LAS unsigned char* lds, unsigned char* ws, const float* cosT, const float* sinT) {
    constexpr int K = PhK<PH>::K, nt = K / BK;
    const int G = gridDim.x, cidx = blockIdx.x;
    const int tid = threadIdx.x, wid = __builtin_amdgcn_readfirstlane(tid >> 6), lane = tid & 63, wr = wid >> 2, wc = wid & 3, fr = lane & 15, fq = lane >> 4;
    unsigned voffA[2], voffB1[2], voffB2[2];
#pragma unroll
    for (int i = 0; i < 2; ++i) { int R, C; stage_rc(tid * 16 + i * 8192, R, C);
        const int Rb1 = (R & ~31) + perm32(R & 31), Rb2 = (R & ~31) + permT(R & 31);
        voffA[i] = (unsigned)(R * K + C) * 2u; voffB1[i] = (unsigned)(Rb1 * K + C) * 2u; voffB2[i] = (unsigned)(Rb2 * K + C) * 2u; }
    const size_t kstep = (size_t)(BK * 2);
    const size_t hstep = (size_t)HALF * K * 2;
    const size_t tstep = 2 * hstep;
    const unsigned ldsw = (unsigned)wid * 1024u;
    const int aoff = lds_byte(wr * 64 + fr, fq * 8), boff = lds_byte(wc * 32 + fr, fq * 8);
#define PG8_SA(b, h) (((b) * 2 + (h)) * HTB)
#define PG8_SB(b, h) ((4 + (b) * 2 + (h)) * HTB)
#define PG8_STAGE(bufoff, gbase, v0, v1) do { \
        __builtin_amdgcn_global_load_lds((const unsigned*)((const char*)(gbase) + (v0)), (LAS unsigned*)(lds + (bufoff) + ldsw), 16, 0, 0); \
        __builtin_amdgcn_global_load_lds((const unsigned*)((const char*)(gbase) + (v1)), (LAS unsigned*)(lds + (bufoff) + ldsw + 8192), 16, 0, 0); } while (0)
#define PG8_LDA(dst, b, h) do { _Pragma("unroll") for (int m = 0; m < 4; ++m) _Pragma("unroll") for (int k = 0; k < 2; ++k) dst[m][k] = *(const LAS bf16x8*)(lds + PG8_SA(b, h) + aoff + m * 2048 + k * 1024); } while (0)
#define PG8_LDB(dst, b, h) do { _Pragma("unroll") for (int n = 0; n < 2; ++n) _Pragma("unroll") for (int k = 0; k < 2; ++k) dst[n][k] = *(const LAS bf16x8*)(lds + PG8_SB(b, h) + boff + n * 2048 + k * 1024); } while (0)
#define PG8_MMA(ai, bj, At, Bt) do { __builtin_amdgcn_s_setprio(1); _Pragma("unroll") for (int m = 0; m < 4; ++m) _Pragma("unroll") for (int n = 0; n < 2; ++n) _Pragma("unroll") for (int k = 0; k < 2; ++k) \
        acc[ai][bj][m][n] = __builtin_amdgcn_mfma_f32_16x16x32_bf16(Bt[n][k], At[m][k], acc[ai][bj][m][n], 0, 0, 0); __builtin_amdgcn_s_setprio(0); } while (0)
#define PG8_WAIT_V(n) asm volatile("s_waitcnt vmcnt(" #n ")" ::: "memory")
#define PG8_WAIT_L(n) asm volatile("s_waitcnt lgkmcnt(" #n ")" ::: "memory")
#define PG8_BAR __builtin_amdgcn_s_barrier()
#define PG8_SCHED __builtin_amdgcn_sched_barrier(0)
    Unit cur, nxt; GDesc gc, gn; int ui = 0;
    if (!next_unit<PH>(ws, 0, G, cidx, cur, gc)) return;
    f32x4 acc[2][2][4][2];
#pragma unroll
    for (int a = 0; a < 2; ++a)
#pragma unroll
        for (int b = 0; b < 2; ++b)
#pragma unroll
            for (int m = 0; m < 4; ++m)
#pragma unroll
                for (int n = 0; n < 2; ++n) acc[a][b][m][n] = (f32x4){0.f, 0.f, 0.f, 0.f};
    bf16x8 At[4][2], B0[2][2], B1[2][2];
    const char* cA = (const char*)gc.A + (size_t)cur.pm * tstep; const char* cB = (const char*)gc.Bt + (size_t)cur.pn * tstep;
    unsigned vbc0 = (gc.mode & 1) ? voffB2[0] : voffB1[0], vbc1 = (gc.mode & 1) ? voffB2[1] : voffB1[1];
    const unsigned va0 = voffA[0], va1 = voffA[1];
    PG8_STAGE(PG8_SB(0, 0), cB, vbc0, vbc1); PG8_STAGE(PG8_SA(0, 0), cA, va0, va1); PG8_STAGE(PG8_SB(0, 1), cB + hstep, vbc0, vbc1); PG8_STAGE(PG8_SA(0, 1), cA + hstep, va0, va1);
    if (wr == 1) PG8_BAR;
    PG8_WAIT_V(4); PG8_BAR;
    PG8_STAGE(PG8_SB(1, 0), cB + kstep, vbc0, vbc1); PG8_STAGE(PG8_SA(1, 0), cA + kstep, va0, va1); PG8_STAGE(PG8_SB(1, 1), cB + hstep + kstep, vbc0, vbc1);
    PG8_WAIT_V(6); PG8_BAR;
    for (;;) {
        const bool has_next = next_unit<PH>(ws, ui + 1, G, cidx, nxt, gn);
        const char* nA = has_next ? (const char*)gn.A + (size_t)nxt.pm * tstep : cA; const char* nB = has_next ? (const char*)gn.Bt + (size_t)nxt.pn * tstep : cB;
        const unsigned vbn0 = has_next ? ((gn.mode & 1) ? voffB2[0] : voffB1[0]) : vbc0, vbn1 = has_next ? ((gn.mode & 1) ? voffB2[1] : voffB1[1]) : vbc1;
        for (int t = 0; t < nt; t += 2) {
            const bool last = (t == nt - 2);
            const char* a1 = cA + (size_t)(t + 1) * kstep;
            const char* a2 = last ? nA : cA + (size_t)(t + 2) * kstep; const char* b2 = last ? nB : cB + (size_t)(t + 2) * kstep;
            const char* a3 = a2 + kstep; const char* b3 = b2 + kstep;
            const unsigned vb0 = last ? vbn0 : vbc0, vb1 = last ? vbn1 : vbc1;
            PG8_LDB(B0, 0, 0); PG8_SCHED; PG8_LDA(At, 0, 0); PG8_STAGE(PG8_SA(1, 1), a1 + hstep, va0, va1);
            PG8_WAIT_L(8); PG8_BAR; PG8_WAIT_L(0); PG8_MMA(0, 0, At, B0); PG8_BAR; PG8_SCHED;
            PG8_LDB(B1, 0, 1); PG8_STAGE(PG8_SB(0, 0), b2, vb0, vb1);
            PG8_BAR; PG8_WAIT_L(0); PG8_MMA(0, 1, At, B1); PG8_BAR;
            PG8_LDA(At, 0, 1); PG8_STAGE(PG8_SA(0, 0), a2, va0, va1);
            PG8_BAR; PG8_WAIT_L(0); PG8_MMA(1, 0, At, B0); PG8_BAR; PG8_SCHED;
            PG8_STAGE(PG8_SB(0, 1), b2 + hstep, vb0, vb1);
            PG8_WAIT_V(6); PG8_BAR; PG8_MMA(1, 1, At, B1); PG8_BAR;
            PG8_LDB(B0, 1, 0); PG8_SCHED; PG8_LDA(At, 1, 0); PG8_STAGE(PG8_SA(0, 1), a2 + hstep, va0, va1);
            PG8_WAIT_L(8); PG8_BAR; PG8_WAIT_L(0); PG8_MMA(0, 0, At, B0); PG8_BAR; PG8_SCHED;
            PG8_LDB(B1, 1, 1); PG8_STAGE(PG8_SB(1, 0), b3, vb0, vb1);
            PG8_BAR; PG8_WAIT_L(0); PG8_MMA(0, 1, At, B1); PG8_BAR;
            PG8_LDA(At, 1, 1); PG8_STAGE(PG8_SA(1, 0), a3, va0, va1);
            PG8_BAR; PG8_WAIT_L(0); PG8_MMA(1, 0, At, B0); PG8_BAR; PG8_SCHED;
            PG8_STAGE(PG8_SB(1, 1), b3 + hstep, vb0, vb1);
            PG8_WAIT_V(6); PG8_BAR; PG8_MMA(1, 1, At, B1); PG8_BAR;
        }
        epilogue(acc, cur, gc, cosT, sinT, wr, wc, fr, fq);
        if (!has_next) break;
#pragma unroll
        for (int a = 0; a < 2; ++a)
#pragma unroll
            for (int b = 0; b < 2; ++b)
#pragma unroll
                for (int m = 0; m < 4; ++m)
#pragma unroll
                    for (int n = 0; n < 2; ++n) acc[a][b][m][n] = (f32x4){0.f, 0.f, 0.f, 0.f};
        cur = nxt; gc = gn; cA = nA; cB = nB; vbc0 = vbn0; vbc1 = vbn1; ++ui;
    }
    PG8_WAIT_V(0);
    if (wr == 0) PG8_BAR;
    PG8_BAR;
#undef PG8_SA
#undef PG8_SB
#undef PG8_STAGE
#undef PG8_LDA
#undef PG8_LDB
#undef PG8_MMA
#undef PG8_WAIT_V
#undef PG8_WAIT_L
#undef PG8_BAR
#undef PG8_SCHED
}
}

#define MFMA32(a, b, c) __builtin_amdgcn_mfma_f32_32x32x16_bf16((a), (b), (c), 0, 0, 0)
constexpr int FL_KSTR = 400, FL_VSTR = 144, FL_KBUF = 64 * FL_KSTR, FL_VBUF = 128 * FL_VSTR;
template <int DQK, bool CAUSAL>
DI void flash_item(LAS unsigned char* lds, const bf16_t* Q, int ldq, const bf16_t* Kp, int ldk, const bf16_t* VT, int ldv,
                   int nkeys, int q0, const bf16_t* gate, int ldg, bf16_t* out, int ldo) {
    constexpr int NKS = DQK / 16;
    constexpr int KSTR = DQK * 2 + 16;
    const int tid = threadIdx.x, w = __builtin_amdgcn_readfirstlane(tid >> 6), lane = tid & 63, ql = lane & 31, h = lane >> 5;
    bf16x8 qf[NKS];
#pragma unroll
    for (int ks = 0; ks < NKS; ++ks) qf[ks] = *(const bf16x8*)(Q + (size_t)(32 * w + ql) * ldq + 16 * ks + 8 * h);
    f32x16 O[4];
#pragma unroll
    for (int i = 0; i < 4; ++i)
#pragma unroll
        for (int j = 0; j < 16; ++j) O[i][j] = 0.f;
    float mrun = -INFINITY, lsum = 0.f;
    const int nt = nkeys / 64;
    const int qmin = q0 + 32 * w, qmax = qmin + 31;
    constexpr int KCHUNKS = (64 * KSTR + 1023) / 1024, VCHUNKS = (128 * FL_VSTR + 1023) / 1024;
    constexpr int KPW = (KCHUNKS + 7) / 8, VPW = (VCHUNKS + 7) / 8;
    unsigned koff[KPW], voff[VPW];
#pragma unroll
    for (int i = 0; i < KPW; ++i) { const int o = (w + 8 * i) * 1024 + lane * 16; int r = o / KSTR, wi = o % KSTR; if (r > 63) r = 63; if (wi >= DQK * 2) wi = 0; koff[i] = (unsigned)(r * ldk * 2 + wi); }
#pragma unroll
    for (int i = 0; i < VPW; ++i) { const int o = (w + 8 * i) * 1024 + lane * 16; int d = o / FL_VSTR, wi = o % FL_VSTR; if (d > 127) d = 127; if (wi >= 128) wi = 0; voff[i] = (unsigned)(d * ldv * 2 + wi); }
#define FL_ISSUE(t, kbuf_, vbuf_) do { const char* kb_ = (const char*)(Kp + (size_t)(t) * 64 * ldk); const char* vb_ = (const char*)(VT + (size_t)(t) * 64); \
        _Pragma("unroll") for (int i = 0; i < KPW; ++i) if (w + 8 * i < KCHUNKS) __builtin_amdgcn_global_load_lds((const unsigned*)(kb_ + koff[i]), (LAS unsigned*)(lds + (kbuf_) * FL_KBUF + (w + 8 * i) * 1024), 16, 0, 0); \
        _Pragma("unroll") for (int i = 0; i < VPW; ++i) if (w + 8 * i < VCHUNKS) __builtin_amdgcn_global_load_lds((const unsigned*)(vb_ + voff[i]), (LAS unsigned*)(lds + 2 * FL_KBUF + (vbuf_) * FL_VBUF + (w + 8 * i) * 1024), 16, 0, 0); } while (0)
#define FL_PV(vbuf_) do { _Pragma("unroll") for (int b = 0; b < 4; ++b) { __builtin_amdgcn_sched_barrier(0); \
        _Pragma("unroll") for (int dt = 0; dt < 4; ++dt) { \
            const bf16x8 vf = *(const LAS bf16x8*)(lds + 2 * FL_KBUF + (vbuf_) * FL_VBUF + (32 * dt + ql) * FL_VSTR + (16 * b + 8 * h) * 2); \
            O[dt] = MFMA32(vf, pf[b], O[dt]); } } } while (0)
    const bool late = (w >= 4);
    bf16x8 pf[4];
#pragma unroll
    for (int b = 0; b < 4; ++b) pf[b] = (bf16x8){0, 0, 0, 0, 0, 0, 0, 0};
    int havep = 0, vb = 0, vprev = 0;
    FL_ISSUE(0, 0, 0);
    for (int t = 0; t < nt; ++t) {
        const int buf = t & 1;
        asm volatile("s_waitcnt vmcnt(0)" ::: "memory");
        __syncthreads();
        const int vnext = (vb == 2) ? 0 : vb + 1;
        if (t + 1 < nt) FL_ISSUE(t + 1, buf ^ 1, vnext);
        if (late && havep) { FL_PV(vprev); havep = 0; }
        const int k0 = t * 64;
        if (!CAUSAL || k0 <= qmax) {
            const float sinit = (t == 0) ? 0.f : -mrun;
            f32x16 S[2];
#pragma unroll
            for (int mt = 0; mt < 2; ++mt) {
                __builtin_amdgcn_sched_barrier(0);
#pragma unroll
                for (int j = 0; j < 16; ++j) S[mt][j] = sinit;
#pragma unroll
                for (int ks = 0; ks < NKS; ++ks) {
                    const bf16x8 kf = *(const LAS bf16x8*)(lds + buf * FL_KBUF + (32 * mt + ql) * KSTR + (16 * ks + 8 * h) * 2);
                    S[mt] = MFMA32(kf, qf[ks], S[mt]);
                }
            }
            if (CAUSAL && k0 + 63 > qmin) {
                const int q = qmin + ql;
#pragma unroll
                for (int mt = 0; mt < 2; ++mt)
#pragma unroll
                    for (int j = 0; j < 16; ++j) { const int key = k0 + 32 * mt + 8 * (j >> 2) + 4 * h + (j & 3); if (key > q) S[mt][j] = -INFINITY; }
            }
            float mx = fmaxf(fmaxf(S[0][0], S[0][1]), S[0][2]);
#pragma unroll
            for (int j = 3; j < 15; j += 2) mx = fmaxf(fmaxf(mx, S[0][j]), S[0][j + 1]);
            mx = fmaxf(mx, S[0][15]);
#pragma unroll
            for (int j = 0; j < 16; j += 2) mx = fmaxf(fmaxf(mx, S[1][j]), S[1][j + 1]);
            mx = fmaxf(mx, __shfl_xor(mx, 32, 64));
            if (t == 0 || __builtin_amdgcn_ballot_w64(mx > 8.f) != 0ull) {
                const float delta = (t == 0) ? mx : fmaxf(mx, 0.f);
                const float alpha = __builtin_amdgcn_exp2f(-delta);
                mrun = (t == 0) ? mx : mrun + delta; lsum *= alpha;
#pragma unroll
                for (int mt = 0; mt < 2; ++mt)
#pragma unroll
                    for (int j = 0; j < 16; ++j) S[mt][j] -= delta;
#pragma unroll
                for (int i = 0; i < 4; ++i)
#pragma unroll
                    for (int j = 0; j < 16; ++j) O[i][j] *= alpha;
            }
            f32x2 ps2 = {0.f, 0.f};
#pragma unroll
            for (int mt = 0; mt < 2; ++mt)
#pragma unroll
                for (int j = 0; j < 16; j += 2) { const float p0 = __builtin_amdgcn_exp2f(S[mt][j]), p1 = __builtin_amdgcn_exp2f(S[mt][j + 1]); S[mt][j] = p0; S[mt][j + 1] = p1; ps2 += (f32x2){p0, p1}; }
            lsum += ps2[0] + ps2[1];
#pragma unroll
            for (int b = 0; b < 4; ++b) {
                const int mt = b >> 1, e0 = 8 * (b & 1);
                u32x4 pw; pw[0] = pk2(S[mt][e0], S[mt][e0 + 1]); pw[1] = pk2(S[mt][e0 + 2], S[mt][e0 + 3]); pw[2] = pk2(S[mt][e0 + 4], S[mt][e0 + 5]); pw[3] = pk2(S[mt][e0 + 6], S[mt][e0 + 7]);
                pf[b] = __builtin_bit_cast(bf16x8, pw);
            }
            havep = 1;
            if (!late) { FL_PV(vb); havep = 0; }
        }
        vprev = vb; vb = vnext;
    }
    if (late && havep) { FL_PV(vprev); }
#undef FL_PV
#undef FL_ISSUE
    const float ltot = lsum + __shfl_xor(lsum, 32, 64);
    const float inv = 1.f / ltot;
    __syncthreads();
    LAS unsigned char* orow = lds + (32 * w + ql) * 272;
#pragma unroll
    for (int dt = 0; dt < 4; ++dt)
#pragma unroll
        for (int g4 = 0; g4 < 4; ++g4) {
            u32x2 o; o[0] = pk2(O[dt][4 * g4] * inv, O[dt][4 * g4 + 1] * inv); o[1] = pk2(O[dt][4 * g4 + 2] * inv, O[dt][4 * g4 + 3] * inv);
            *(LAS u32x2*)(orow + (32 * dt + 8 * g4 + 4 * h) * 2) = o;
        }
#pragma unroll
    for (int i = 0; i < 8; ++i) {
        const int id = lane + 64 * i, r = 32 * w + (id >> 4), cc = id & 15;
        const u32x4 ov = *(const LAS u32x4*)(lds + r * 272 + cc * 16);
        const u32x4 gz = *(const u32x4*)(gate + (size_t)r * ldg + cc * 8);
        u32x4 res;
#pragma unroll
        for (int e = 0; e < 4; ++e) res[e] = pk2(bflo(ov[e]) * silu(bflo(gz[e])), bfhi(ov[e]) * silu(bfhi(gz[e])));
        *(u32x4*)(out + (size_t)r * ldo + cc * 8) = res;
    }
    __syncthreads();
}

DI void mem_item(const Ctx& c, int it, const bf16_t* proj, int ldp, int col_mq, int col_mz, const bf16_t* memK, const bf16_t* memVT, bf16_t* mix) {
    const int qb = it & 15, mh = (it >> 4) & 3, b = it >> 6;
    const size_t row0 = (size_t)b * SEQ + 256 * qb;
    flash_item<128, false>(c.lds, proj + row0 * ldp + col_mq + mh * 128, ldp, memK + (size_t)(b * 256) * 512 + mh * 128, 512,
                           memVT + (size_t)(mh * 128) * 1024 + b * 256, 1024, 256, 0, proj + row0 * ldp + col_mz + mh * 128, ldp, mix + row0 * 2048 + 1536 + mh * 128, 2048);
}

DI float log_sigmoid(float x) { return fminf(x, 0.f) - __logf(1.f + __expf(-fabsf(x))); }
constexpr int GL_G = 0;
constexpr int GL_RED = 4096;
constexpr int GL_TOT = 5120;
constexpr int GL_Q = 12288;
constexpr int GL_K = GL_Q + 25600;
constexpr int GL_KT = GL_K + 25600;
constexpr int GL_O = GL_K + 25600;
DI void gla_prep(const Ctx& c, const bf16_t* projA, size_t tok0, int hh, float* dv, const int tid) {
    LAS float* sg = (LAS float*)(c.lds + GL_G);
#pragma unroll
    for (int i = 0; i < 2; ++i) { const int id = tid + NTHR * i, t = id >> 4, r = id & 15; sg[id] = bf2f(projA[(tok0 + t) * NA + A_G + r]); }
#pragma unroll
    for (int i = 0; i < 3; ++i) { const int id = tid + NTHR * i, r = id / 24, cc = id % 24;
        *(LAS u32x4*)(c.lds + GL_K + r * 400 + cc * 16) = *(const u32x4*)(projA + (tok0 + r) * NA + A_K + hh * 192 + cc * 8);
        *(LAS u32x4*)(c.lds + GL_Q + r * 400 + cc * 16) = *(const u32x4*)(projA + (tok0 + r) * NA + A_Q + hh * 192 + cc * 8); }
    const int tg = tid >> 6, lane = tid & 63;
    const float* wg2 = c.in(5) + hh * 192 + lane; const float* bg = c.in(6) + hh * 192 + lane;
    float wg[3][16], bias[3];
#pragma unroll
    for (int ci = 0; ci < 3; ++ci) { bias[ci] = bg[64 * ci];
#pragma unroll
        for (int r = 0; r < 16; ++r) wg[ci][r] = wg2[r * 768 + 64 * ci]; }
    __syncthreads();
    float cl[3][8]; float run[3] = {0.f, 0.f, 0.f};
    LAS float* tot = (LAS float*)(c.lds + GL_TOT);
#pragma unroll
    for (int i = 0; i < 8; ++i) {
        const int t = 8 * tg + i;
        f32x4 g4[4];
#pragma unroll
        for (int r4 = 0; r4 < 4; ++r4) g4[r4] = *(const LAS f32x4*)(sg + t * 16 + 4 * r4);
#pragma unroll
        for (int ci = 0; ci < 3; ++ci) {
            float x = bias[ci];
#pragma unroll
            for (int r4 = 0; r4 < 4; ++r4) x += g4[r4][0] * wg[ci][4 * r4] + g4[r4][1] * wg[ci][4 * r4 + 1] + g4[r4][2] * wg[ci][4 * r4 + 2] + g4[r4][3] * wg[ci][4 * r4 + 3];
            run[ci] += log_sigmoid(x) * (1.f / 16.f); cl[ci][i] = run[ci];
        }
    }
#pragma unroll
    for (int ci = 0; ci < 3; ++ci) tot[tg * 192 + lane + 64 * ci] = run[ci];
    __syncthreads();
#pragma unroll
    for (int ci = 0; ci < 3; ++ci) {
        const int j = lane + 64 * ci;
        float off = 0.f, last = 0.f;
#pragma unroll
        for (int g = 0; g < 8; ++g) { const float tv = tot[g * 192 + j]; last += tv; if (g < tg) off += tv; }
        if (tg == 0) dv[j] = __expf(last);
        float kh[8];
#pragma unroll
        for (int i = 0; i < 8; ++i) {
            const int t = 8 * tg + i; const float cum = cl[ci][i] + off;
            LAS bf16_t* qp = (LAS bf16_t*)(c.lds + GL_Q + t * 400 + j * 2); LAS bf16_t* kp = (LAS bf16_t*)(c.lds + GL_K + t * 400 + j * 2);
            const float kv = bf2f(*kp);
            *qp = f2bf(bf2f(*qp) * __expf(cum)); *kp = f2bf(kv * __expf(-cum));
            kh[i] = kv * __expf(last - cum);
        }
        const int blk = (tg >> 1) * 16, p0 = tokperm16((tg & 1) * 8), p1 = tokperm16((tg & 1) * 8 + 4);
        u32x2 w0, w1; w0[0] = pk2(kh[0], kh[1]); w0[1] = pk2(kh[2], kh[3]); w1[0] = pk2(kh[4], kh[5]); w1[1] = pk2(kh[6], kh[7]);
        *(LAS u32x2*)(c.lds + GL_KT + j * 144 + (blk + p0) * 2) = w0;
        *(LAS u32x2*)(c.lds + GL_KT + j * 144 + (blk + p1) * 2) = w1;
    }
    __syncthreads();
}
DI void gla_local_item(const Ctx& c, int item) {
    const int hh = item & 3, ch = (item >> 2) & 63, b = item >> 8;
    const size_t tok0 = (size_t)b * SEQ + 64 * ch;
    const bf16_t* projA = (const bf16_t*)(c.ws + O_PROJ);
    const bf16_t* vT = (const bf16_t*)(c.ws + O_VT);
    bf16_t* st = (bf16_t*)(c.ws + O_ST) + (size_t)item * 73728;
    float* dv = (float*)(c.ws + O_DVEC) + (size_t)item * 192;
    int tid = threadIdx.x; asm volatile("" : "+v"(tid));
    const int w = __builtin_amdgcn_readfirstlane(tid >> 6), lane = tid & 63, ql = lane & 31, h = lane >> 5;
    const int jg = w & 1, vg = w >> 1;
    bf16x8 vf[3][4];
#pragma unroll
    for (int vt = 0; vt < 3; ++vt)
#pragma unroll
        for (int ks = 0; ks < 4; ++ks) vf[vt][ks] = *(const bf16x8*)(vT + ((((size_t)(hh * 12 + 3 * vg + vt) * (T / 64) + (tok0 >> 6)) * 4 + ks) * 64 + lane) * 8);
    gla_prep(c, projA, tok0, hh, dv, tid);
    bf16_t* projW = (bf16_t*)(c.ws + O_PROJ);
#pragma unroll
    for (int i = 0; i < 3; ++i) { const int id = tid + NTHR * i, r = id / 24, cc = id % 24;
        *(u32x4*)(projW + (tok0 + r) * NA + A_K + hh * 192 + cc * 8) = *(const LAS u32x4*)(c.lds + GL_K + r * 400 + cc * 16);
        *(u32x4*)(projW + (tok0 + r) * NA + A_Q + hh * 192 + cc * 8) = *(const LAS u32x4*)(c.lds + GL_Q + r * 400 + cc * 16); }
    f32x16 U[3][3];
#pragma unroll
    for (int a = 0; a < 3; ++a)
#pragma unroll
        for (int bq = 0; bq < 3; ++bq)
#pragma unroll
            for (int i = 0; i < 16; ++i) U[a][bq][i] = 0.f;
#pragma unroll
    for (int ks = 0; ks < 4; ++ks)
#pragma unroll
        for (int jt = 0; jt < 3; ++jt) {
            const bf16x8 kf = *(const LAS bf16x8*)(c.lds + GL_KT + (32 * (3 * jg + jt) + ql) * 144 + (16 * ks + 8 * h) * 2);
#pragma unroll
            for (int vt = 0; vt < 3; ++vt) U[jt][vt] = MFMA32(kf, vf[vt][ks], U[jt][vt]);
        }
#pragma unroll
    for (int jt = 0; jt < 3; ++jt)
#pragma unroll
        for (int vt = 0; vt < 3; ++vt)
#pragma unroll
            for (int g4 = 0; g4 < 4; ++g4) {
                const int ks = 2 * (3 * jg + jt) + (g4 >> 1);
                u32x2 o; o[0] = pk2(U[jt][vt][4 * g4], U[jt][vt][4 * g4 + 1]); o[1] = pk2(U[jt][vt][4 * g4 + 2], U[jt][vt][4 * g4 + 3]);
                *(u32x2*)(st + (size_t)(((3 * vg + vt) * 12 + ks) * 64 + ql + 32 * (g4 & 1)) * 8 + 4 * h) = o;
            }
    __syncthreads();
}
template <int GD> struct ScanGrp { u32x4 u[GD]; f32x4 d0[GD], d1[GD]; };
template <int GD> DI void scan_load(ScanGrp<GD>& g, const bf16_t* stb, const float* dvb, int b, int hh, int e, int j0, int ch0) {
#pragma unroll
    for (int i = 0; i < GD; ++i) { const size_t item = (size_t)(b * 64 + ch0 + i) * 4 + hh;
        g.u[i] = ldnt_u4(stb + item * 73728 + (size_t)e * 8); g.d0[i] = *(const f32x4*)(dvb + item * 192 + j0); g.d1[i] = *(const f32x4*)(dvb + item * 192 + j0 + 4); }
}
template <int GD> DI void scan_apply(const ScanGrp<GD>& g, float (&s)[8], bf16_t* stb, int b, int hh, int e, int ch0) {
#pragma unroll
    for (int i = 0; i < GD; ++i) { const size_t item = (size_t)(b * 64 + ch0 + i) * 4 + hh;
        u32x4 o; o[0] = pk2(s[0], s[1]); o[1] = pk2(s[2], s[3]); o[2] = pk2(s[4], s[5]); o[3] = pk2(s[6], s[7]);
        *(u32x4*)(stb + item * 73728 + (size_t)e * 8) = o;
        const u32x4 u = g.u[i]; const f32x4 d0 = g.d0[i], d1 = g.d1[i];
        s[0] = d0[0] * s[0] + bflo(u[0]); s[1] = d0[1] * s[1] + bfhi(u[0]); s[2] = d0[2] * s[2] + bflo(u[1]); s[3] = d0[3] * s[3] + bfhi(u[1]);
        s[4] = d1[0] * s[4] + bflo(u[2]); s[5] = d1[1] * s[5] + bfhi(u[2]); s[6] = d1[2] * s[6] + bflo(u[3]); s[7] = d1[3] * s[7] + bfhi(u[3]); }
}
template <int NEL, int GD>
DI void gla_scan_thread(bf16_t* stb, const float* dvb, int idx0, int stride) {
    int b[NEL], hh[NEL], e[NEL], j0[NEL]; float s[NEL][8]; ScanGrp<GD> ga[NEL], gb[NEL];
#pragma unroll
    for (int k = 0; k < NEL; ++k) { const int idx = idx0 + k * stride, bh = idx / 9216; e[k] = idx % 9216; b[k] = bh >> 2; hh[k] = bh & 3; j0[k] = 16 * ((e[k] >> 6) % 12) + 8 * ((e[k] >> 5) & 1);
#pragma unroll
        for (int i = 0; i < 8; ++i) s[k][i] = 0.f;
        scan_load<GD>(ga[k], stb, dvb, b[k], hh[k], e[k], j0[k], 0); }
    for (int ch0 = 0; ch0 < 64; ch0 += 2 * GD) {
#pragma unroll
        for (int k = 0; k < NEL; ++k) scan_load<GD>(gb[k], stb, dvb, b[k], hh[k], e[k], j0[k], ch0 + GD);
#pragma unroll
        for (int k = 0; k < NEL; ++k) scan_apply<GD>(ga[k], s[k], stb, b[k], hh[k], e[k], ch0);
        if (ch0 + 2 * GD < 64) {
#pragma unroll
            for (int k = 0; k < NEL; ++k) scan_load<GD>(ga[k], stb, dvb, b[k], hh[k], e[k], j0[k], ch0 + 2 * GD);
        }
#pragma unroll
        for (int k = 0; k < NEL; ++k) scan_apply<GD>(gb[k], s[k], stb, b[k], hh[k], e[k], ch0 + GD);
    }
}
DI void gla_scan(const Ctx& c) {
    bf16_t* stb = (bf16_t*)(c.ws + O_ST); const float* dvb = (const float*)(c.ws + O_DVEC);
    const int total = 16 * 9216, per = (total + (int)gridDim.x - 1) / (int)gridDim.x;
    const int lo = blockIdx.x * per, hi = (lo + per < total) ? lo + per : total;
    for (int base = lo; base < hi; base += 2 * NTHR) {
        const int i0 = base + threadIdx.x, i1 = i0 + NTHR;
        if (i1 < hi) gla_scan_thread<2, 2>(stb, dvb, i0, NTHR);
        else if (i0 < hi) gla_scan_thread<1, 4>(stb, dvb, i0, 0);
    }
}
struct GlaPre { u32x4 kq[6]; bf16x8 sfA[12]; };
DI void gla_out_prefetch(const Ctx& c, int item, int tid, GlaPre& P) {
    const int hh = item & 3, ch = (item >> 2) & 63, b = item >> 8;
    const size_t tok0 = (size_t)b * SEQ + 64 * ch;
    const bf16_t* projA = (const bf16_t*)(c.ws + O_PROJ);
    const bf16_t* st = (const bf16_t*)(c.ws + O_ST) + (size_t)item * 73728;
    const int w = __builtin_amdgcn_readfirstlane(tid >> 6), lane = tid & 63, ql = lane & 31, h = lane >> 5, vg = w >> 1;
#pragma unroll
    for (int ks = 0; ks < 12; ++ks) P.sfA[ks] = __builtin_nontemporal_load((const bf16x8*)(st + (size_t)(((3 * vg) * 12 + ks) * 64 + lane) * 8));
#pragma unroll
    for (int i = 0; i < 3; ++i) { const int id = tid + NTHR * i, r = id / 24, cc = id % 24;
        P.kq[2 * i] = *(const u32x4*)(projA + (tok0 + r) * NA + A_K + hh * 192 + cc * 8);
        P.kq[2 * i + 1] = *(const u32x4*)(projA + (tok0 + r) * NA + A_Q + hh * 192 + cc * 8); }
}
DI void gla_out_phase(const Ctx& c) {
  GlaPre P;
  if ((int)blockIdx.x < 1024) gla_out_prefetch(c, blockIdx.x, threadIdx.x, P);
  for (int item = blockIdx.x; item < 1024; item += gridDim.x) {
    const int hh = item & 3, ch = (item >> 2) & 63, b = item >> 8;
    const size_t tok0 = (size_t)b * SEQ + 64 * ch;
    const bf16_t* projA = (const bf16_t*)(c.ws + O_PROJ);
    const bf16_t* vT = (const bf16_t*)(c.ws + O_VT);
    const bf16_t* st = (const bf16_t*)(c.ws + O_ST) + (size_t)item * 73728;
    bf16_t* mix = (bf16_t*)(c.ws + O_H);
    int tid = threadIdx.x; asm volatile("" : "+v"(tid));
    const int w = __builtin_amdgcn_readfirstlane(tid >> 6), lane = tid & 63, ql = lane & 31, h = lane >> 5;
    const int tt = w & 1, vg = w >> 1;
    bf16x8 sfB[12];
#pragma unroll
    for (int i = 0; i < 3; ++i) { const int id = tid + NTHR * i, r = id / 24, cc = id % 24;
        *(LAS u32x4*)(c.lds + GL_K + r * 400 + cc * 16) = P.kq[2 * i];
        *(LAS u32x4*)(c.lds + GL_Q + r * 400 + cc * 16) = P.kq[2 * i + 1]; }
    __syncthreads();
    bf16x8 qf[12];
#pragma unroll
    for (int ks = 0; ks < 12; ++ks) qf[ks] = *(const LAS bf16x8*)(c.lds + GL_Q + (32 * tt + ql) * 400 + (16 * ks + 8 * h) * 2);
    bf16x8 pf[4];
#pragma unroll
    for (int stl = 0; stl < 2; ++stl) {
        f32x16 Sx;
#pragma unroll
        for (int i = 0; i < 16; ++i) Sx[i] = 0.f;
        if (stl <= tt) {
#pragma unroll
            for (int ks = 0; ks < 12; ++ks) {
                const bf16x8 kf = *(const LAS bf16x8*)(c.lds + GL_K + (32 * stl + ql) * 400 + (16 * ks + 8 * h) * 2);
                Sx = MFMA32(kf, qf[ks], Sx);
            }
            if (stl == tt) {
#pragma unroll
                for (int i = 0; i < 16; ++i) { const int s = 8 * (i >> 2) + 4 * h + (i & 3); if (s > ql) Sx[i] = 0.f; }
            }
        }
#pragma unroll
        for (int bq = 0; bq < 2; ++bq) { const int e0 = 8 * bq;
            u32x4 pw; pw[0] = pk2(Sx[e0], Sx[e0 + 1]); pw[1] = pk2(Sx[e0 + 2], Sx[e0 + 3]); pw[2] = pk2(Sx[e0 + 4], Sx[e0 + 5]); pw[3] = pk2(Sx[e0 + 6], Sx[e0 + 7]);
            pf[2 * stl + bq] = __builtin_bit_cast(bf16x8, pw); }
    }
    __builtin_amdgcn_sched_barrier(0);
#pragma unroll
    for (int ks = 0; ks < 12; ++ks) sfB[ks] = __builtin_nontemporal_load((const bf16x8*)(st + (size_t)(((3 * vg + 1) * 12 + ks) * 64 + lane) * 8));
    float ssq = 0.f;
#pragma unroll
    for (int vt = 0; vt < 3; ++vt) {
        const int v = 32 * (3 * vg + vt) + ql;
        bf16x8 vf[4];
#pragma unroll
        for (int bq = 0; bq < 4; ++bq) vf[bq] = *(const bf16x8*)(vT + ((((size_t)(hh * 12 + 3 * vg + vt) * (T / 64) + (tok0 >> 6)) * 4 + bq) * 64 + lane) * 8);
        f32x16 Oa;
#pragma unroll
        for (int i = 0; i < 16; ++i) Oa[i] = 0.f;
#pragma unroll
        for (int ks = 0; ks < 12; ++ks) Oa = MFMA32((vt == 1 ? sfB[ks] : P.sfA[ks]), qf[ks], Oa);
        if (vt == 0) {
#pragma unroll
            for (int ks = 0; ks < 12; ++ks) P.sfA[ks] = __builtin_nontemporal_load((const bf16x8*)(st + (size_t)(((3 * vg + 2) * 12 + ks) * 64 + lane) * 8));
        }
#pragma unroll
        for (int bq = 0; bq < 4; ++bq) if ((bq >> 1) <= tt) Oa = MFMA32(vf[bq], pf[bq], Oa);
#pragma unroll
        for (int i = 0; i < 16; ++i) ssq += Oa[i] * Oa[i];
#pragma unroll
        for (int g4 = 0; g4 < 4; ++g4) { u32x2 o; o[0] = pk2(Oa[4 * g4], Oa[4 * g4 + 1]); o[1] = pk2(Oa[4 * g4 + 2], Oa[4 * g4 + 3]);
            *(LAS u32x2*)(c.lds + GL_O + (32 * tt + ql) * 784 + (32 * (3 * vg + vt) + 8 * g4 + 4 * h) * 2) = o; }
    }
    if (item + (int)gridDim.x < 1024) gla_out_prefetch(c, item + gridDim.x, tid, P);
    ssq += __shfl_xor(ssq, 32, 64);
    LAS float* red = (LAS float*)(c.lds + GL_RED);
    if (h == 0) red[vg * 64 + 32 * tt + ql] = ssq;
    __syncthreads();
    const float* gg = c.in(7);
#pragma unroll
    for (int i = 0; i < 6; ++i) {
        const int id = tid + NTHR * i, t = id / 48, v0 = (id % 48) * 8;
        const float tot = red[t] + red[64 + t] + red[128 + t] + red[192 + t];
        const float rr = rsqrtf(tot * (1.f / 384.f) + EPS);
        const size_t tok = tok0 + t;
        const u32x4 o8 = *(const LAS u32x4*)(c.lds + GL_O + t * 784 + v0 * 2);
        const u32x4 z8 = ldnt_u4(projA + tok * NA + A_Z + hh * 384 + v0);
        const f32x4 g0 = *(const f32x4*)(gg + v0), g1 = *(const f32x4*)(gg + v0 + 4);
        u32x4 r;
        r[0] = pk2(bflo(o8[0]) * rr * g0[0] * silu(bflo(z8[0])), bfhi(o8[0]) * rr * g0[1] * silu(bfhi(z8[0])));
        r[1] = pk2(bflo(o8[1]) * rr * g0[2] * silu(bflo(z8[1])), bfhi(o8[1]) * rr * g0[3] * silu(bfhi(z8[1])));
        r[2] = pk2(bflo(o8[2]) * rr * g1[0] * silu(bflo(z8[2])), bfhi(o8[2]) * rr * g1[1] * silu(bfhi(z8[2])));
        r[3] = pk2(bflo(o8[3]) * rr * g1[2] * silu(bflo(z8[3])), bfhi(o8[3]) * rr * g1[3] * silu(bfhi(z8[3])));
        *(u32x4*)(mix + tok * 2048 + hh * 384 + v0) = r;
    }
    __syncthreads();
  }
}

template <bool WITH_H>
DI void post_rows(const float* xin, const bf16_t* y, const float* g, float* xo, bf16_t* hn) {
    const int lane = threadIdx.x & 63, wv = threadIdx.x >> 6;
    f32x4 gv[8];
#pragma unroll
    for (int k = 0; k < 8; ++k) gv[k] = *(const f32x4*)(g + 4 * lane + 256 * k);
    for (int r0 = (blockIdx.x * 8 + wv) * 2; r0 < T; r0 += gridDim.x * 16) {
        u32x2 yu[2][8]; f32x4 xv[2][8];
#pragma unroll
        for (int rr = 0; rr < 2; ++rr)
#pragma unroll
            for (int k = 0; k < 8; ++k) {
                yu[rr][k] = ldnt_u2(y + (size_t)(r0 + rr) * 2048 + 4 * lane + 256 * k);
                xv[rr][k] = ldnt_f4(xin + (size_t)(r0 + rr) * 2048 + 4 * lane + 256 * k);
            }
#pragma unroll
        for (int rr = 0; rr < 2; ++rr) {
            const int r = r0 + rr;
            f32x4 yv[8]; float ss = 0.f;
#pragma unroll
            for (int k = 0; k < 8; ++k) { yv[k] = (f32x4){bflo(yu[rr][k][0]), bfhi(yu[rr][k][0]), bflo(yu[rr][k][1]), bfhi(yu[rr][k][1])};
                ss += yv[k][0] * yv[k][0] + yv[k][1] * yv[k][1] + yv[k][2] * yv[k][2] + yv[k][3] * yv[k][3]; }
            ss = wave_sum(ss); const float rs = rsqrtf(ss * (1.f / 2048.f) + EPS);
            float s1 = 0.f;
#pragma unroll
            for (int k = 0; k < 8; ++k) {
                const f32x4 o = xv[rr][k] + yv[k] * rs * gv[k];
                s1 += o[0] * o[0] + o[1] * o[1] + o[2] * o[2] + o[3] * o[3];
                yv[k] = o;
                stnt_f4(xo + (size_t)r * 2048 + 4 * lane + 256 * k, o);
            }
            if (WITH_H) {
                s1 = wave_sum(s1); const float r1 = rsqrtf(s1 * (1.f / 2048.f) + EPS);
#pragma unroll
                for (int k = 0; k < 8; ++k) { u32x2 w2; w2[0] = pk2(yv[k][0] * r1, yv[k][1] * r1); w2[1] = pk2(yv[k][2] * r1, yv[k][3] * r1);
                    *(u32x2*)(hn + (size_t)r * 2048 + 4 * lane + 256 * k) = w2; }
            }
        }
    }
}
DI void phase6(const Ctx& c) {
    const bf16_t* projB = (const bf16_t*)(c.ws + O_PROJ);
    bf16_t* cn = (bf16_t*)(c.ws + O_CN); bf16_t* cqn = (bf16_t*)(c.ws + O_CQN); bf16_t* kf = (bf16_t*)(c.ws + O_KF);
    float* cosT = (float*)(c.ws + O_COS); float* sinT = (float*)(c.ws + O_SIN);
    const int* pos = (const int*)c.in(2);
    const int lane = threadIdx.x & 63, wv = threadIdx.x >> 6;
    for (int r0 = (blockIdx.x * 8 + wv) * 2; r0 < T; r0 += gridDim.x * 16) {
        u32x4 uc[2], uq[2];
#pragma unroll
        for (int rr = 0; rr < 2; ++rr) { const bf16_t* pr = projB + (size_t)(r0 + rr) * NBI; uc[rr] = *(const u32x4*)(pr + B_C + 8 * lane); uq[rr] = *(const u32x4*)(pr + B_CQ + 8 * lane); }
        const int rme = r0 + (lane >> 5), i = lane & 31;
        const bf16_t* prm = projB + (size_t)rme * NBI;
        const float x1 = bf2f(prm[B_KR + i]), x2 = bf2f(prm[B_KR + 32 + i]);
        const float pz = (float)pos[rme];
#pragma unroll
        for (int rr = 0; rr < 2; ++rr) {
            const int r = r0 + rr;
            float cv[8], qv[8]; float sc = 0.f, sq = 0.f;
#pragma unroll
            for (int e = 0; e < 4; ++e) { cv[2 * e] = bflo(uc[rr][e]); cv[2 * e + 1] = bfhi(uc[rr][e]); qv[2 * e] = bflo(uq[rr][e]); qv[2 * e + 1] = bfhi(uq[rr][e]); }
#pragma unroll
            for (int e = 0; e < 8; ++e) { sc += cv[e] * cv[e]; sq += qv[e] * qv[e]; }
            sc = wave_sum(sc); sq = wave_sum(sq);
            const float rc = rsqrtf(sc * (1.f / 512.f) + EPS), rq = rsqrtf(sq * (1.f / 512.f) + EPS);
            u32x4 oc, oq;
#pragma unroll
            for (int e = 0; e < 4; ++e) { oc[e] = pk2(cv[2 * e] * rc, cv[2 * e + 1] * rc); oq[e] = pk2(qv[2 * e] * rq, qv[2 * e + 1] * rq); }
            *(u32x4*)(cn + (size_t)r * 512 + 8 * lane) = oc; *(u32x4*)(cqn + (size_t)r * 512 + 8 * lane) = oq;
        }
        {
            const float freq = exp2f(-(float)i * (13.287712379549449f / 32.f));
            float sn, cs; sincosf(pz * freq, &sn, &cs);
            cosT[(size_t)rme * 32 + i] = cs; sinT[(size_t)rme * 32 + i] = sn;
            const float o1 = x1 * cs - x2 * sn, o2 = x2 * cs + x1 * sn;
            const float a1 = __shfl_down(o1, 1, 64), a2 = __shfl_down(o1, 2, 64), a3 = __shfl_down(o1, 3, 64);
            const float b1 = __shfl_down(o2, 1, 64), b2 = __shfl_down(o2, 2, 64), b3 = __shfl_down(o2, 3, 64);
            if ((i & 3) == 0) {
                u32x4 w; w[0] = pk2(o1, a1); w[1] = pk2(a2, a3); w[2] = pk2(o2, b1); w[3] = pk2(b2, b3);
#pragma unroll
                for (int hd = 0; hd < 12; ++hd) *(u32x4*)(kf + (size_t)rme * 2304 + hd * 192 + 128 + 2 * i) = w;
            }
        }
    }
}

#define XB_TMO      128
#define XB_XCNT(j)  (256  + 64 * (j))
#define XB_XSUB(j)  (1280 + 64 * (j))
#define XB_XGEN(j)  (2304 + 64 * (j))
#define XB_TOP      3328
#define XB_TOPGEN   3392
#define XCD_BAR_WORDS 3456
#define XB_SPIN_CAP (1u << 18)

__device__ __forceinline__ unsigned xb_ld(unsigned* p)              { return __hip_atomic_load(p, __ATOMIC_RELAXED, __HIP_MEMORY_SCOPE_AGENT); }
__device__ __forceinline__ unsigned xb_add(unsigned* p, unsigned v) { return __hip_atomic_fetch_add(p, v, __ATOMIC_RELAXED, __HIP_MEMORY_SCOPE_AGENT); }
__device__ __forceinline__ unsigned xb_xcc_id() { return (unsigned)__builtin_amdgcn_s_getreg((3 << 11) | 20) & 0xFu; }
#define XB_SPIN(cond, bar) do { unsigned _sp = 0; while (cond) { __builtin_amdgcn_s_sleep(1); \
    if ((++_sp & 255u) == 0u) { if (xb_ld(&(bar)[XB_TMO])) break; if (_sp > XB_SPIN_CAP) { atomicAdd(&(bar)[XB_TMO], 1u); break; } } } } while (0)

struct XcdBarrier {
    unsigned* bar; unsigned x;
    volatile LAS unsigned* st;
};

__device__ __forceinline__ XcdBarrier xcd_barrier_post(unsigned* bar, volatile LAS unsigned* st) {
    XcdBarrier b; b.bar = bar; b.x = xb_xcc_id(); b.st = st;
    if (threadIdx.x == 0) (void)xb_add(&bar[XB_XCNT(b.x)], 1u);
    return b;
}
__device__ __forceinline__ void xcd_barrier_complete(unsigned* bar, unsigned x, unsigned& nloc, unsigned& nx) {
    const unsigned G = gridDim.x * gridDim.y * gridDim.z;
    unsigned sum, cnt, mine, sp = 0u;
    for (;;) {
        sum = 0u; cnt = 0u; mine = 0u;
#pragma unroll
        for (unsigned j = 0; j < 16; ++j) { const unsigned c = xb_ld(&bar[XB_XCNT(j)]); sum += c; cnt += (c > 0u) ? 1u : 0u; mine = (j == x) ? c : mine; }
        if (sum == G) break;
        __builtin_amdgcn_s_sleep(1);
        if ((++sp & 255u) == 0u) { if (xb_ld(&bar[XB_TMO])) break; if (sp > XB_SPIN_CAP) { atomicAdd(&bar[XB_TMO], 1u); break; } }
    }
    nloc = mine > 0u ? mine : 1u; nx = cnt > 0u ? cnt : 1u;
}

__device__ __forceinline__ void xcd_barrier(const XcdBarrier& b) {
    asm volatile("s_waitcnt vmcnt(0)" ::: "memory");
    __syncthreads();
    if (threadIdx.x == 0) {
        unsigned* bar = b.bar;
        __builtin_amdgcn_s_waitcnt(0);
        unsigned nloc = b.st[0], nx = b.st[1];
        if (nloc == 0u) { xcd_barrier_complete(bar, b.x, nloc, nx); b.st[0] = nloc; b.st[1] = nx; }
        const unsigned old = xb_add(&bar[XB_XSUB(b.x)], 1u);
        const unsigned gen = old / nloc;
        if (old + 1u == (gen + 1u) * nloc) {
            __builtin_amdgcn_fence(__ATOMIC_RELEASE, "agent");
            asm volatile("s_waitcnt vmcnt(0)" ::: "memory");
            const unsigned og = xb_add(&bar[XB_TOP], 1u);
            const unsigned tg = og / nx;
            if (og + 1u == (tg + 1u) * nx) xb_add(&bar[XB_TOPGEN], 1u);
            else XB_SPIN(xb_ld(&bar[XB_TOPGEN]) == tg, bar);
            __builtin_amdgcn_fence(__ATOMIC_ACQUIRE, "agent");
            xb_add(&bar[XB_XGEN(b.x)], 1u);
            asm volatile("s_waitcnt vmcnt(0)" ::: "memory");
        } else {
            XB_SPIN(xb_ld(&bar[XB_XGEN(b.x)]) == gen, bar);
            __builtin_amdgcn_fence(__ATOMIC_ACQUIRE, "agent");
            asm volatile("s_waitcnt vmcnt(0)" ::: "memory");
        }
    }
    __syncthreads();
}


constexpr int LDS_CTL = 131072;
constexpr int LDS_BYTES = 131072 + 64;
struct Args { const float* in[25]; float* out; unsigned char* ws; int ph_lo, ph_hi; };

__global__ void __launch_bounds__(NTHR, 2) yoco_fwd(Args a) {
    extern __shared__ __attribute__((aligned(16))) unsigned char lds_raw[];
    cg::grid_group grid = cg::this_grid();
    Ctx c;
    c.ka = (kargp_t)__builtin_amdgcn_kernarg_segment_ptr();
    c.out = a.out; c.ws = a.ws; c.lds = (LAS unsigned char*)lds_raw;
    const int lo = a.ph_lo, hi = a.ph_hi;
    volatile LAS unsigned* xbst = (volatile LAS unsigned*)(c.lds + LDS_CTL);
    if (threadIdx.x < 4) xbst[threadIdx.x] = 0u;
    __syncthreads();
    XcdBarrier xbar = xcd_barrier_post((unsigned*)(c.ws + O_CTL) + 64, xbst);
    const float* cosT = (const float*)(c.ws + O_COS); const float* sinT = (const float*)(c.ws + O_SIN);
#define IN(k) (lo <= (k) && (k) < hi)
#ifndef DBLMASK
#define DBLMASK 0
#endif
#define REPS(k) for (int rep_ = 0; rep_ < (((DBLMASK >> (k)) & 1) ? 2 : 1); ++rep_)
#define SEAM(k) do { if (IN(k) && IN((k) + 1)) xcd_barrier(xbar); } while (0)
    if (hi == 9999) grid.sync();
    if (IN(0)) REPS(0) phase0(c);
    SEAM(0);
    if (IN(1)) { pg8::gemm_phase<1>(c.lds, c.ws, cosT, sinT); conv_fill(c, 1504, 2, 2); }
    SEAM(1);
    if (IN(2)) {
        for (int s = 0; s < 2; ++s) {
            if (((s ^ (int)blockIdx.x) & 1) == 0) { for (int it = blockIdx.x; it < 1024; it += gridDim.x) gla_local_item(c, it); }
            else { for (int it = blockIdx.x; it < 256; it += gridDim.x)
                mem_item(c, it, (const bf16_t*)(c.ws + O_PROJ), NA, A_MQ, A_MZ, (const bf16_t*)(c.ws + O_MEMK_A), (const bf16_t*)(c.ws + O_MEMVT_A), (bf16_t*)(c.ws + O_H)); }
        }
    }
    SEAM(2);
    if (IN(3)) gla_scan(c);
    SEAM(3);
    if (IN(4)) gla_out_phase(c);
    SEAM(4);
    if (IN(5)) REPS(5) pg8::gemm_phase<3>(c.lds, c.ws, cosT, sinT);
    SEAM(5);
    if (IN(6)) REPS(6) post_rows<true>(c.in(0), (const bf16_t*)(c.ws + O_PROJ), c.in(11), c.out, (bf16_t*)(c.ws + O_H));
    SEAM(6);
    if (IN(7)) { pg8::gemm_phase<5>(c.lds, c.ws, cosT, sinT); conv_fill(c, 960, 8, 11); }
    SEAM(7);
    if (IN(8)) REPS(8) phase6(c);
    SEAM(8);
    const int p9_rem = 1344 % (int)gridDim.x, mem_early = (p9_rem == 0) ? 0 : (((int)gridDim.x - p9_rem) < 256 ? ((int)gridDim.x - p9_rem) : 256);
    if (IN(9)) {
        pg8::gemm_phase<7>(c.lds, c.ws, cosT, sinT);
        if (p9_rem != 0 && (int)blockIdx.x >= p9_rem && (int)blockIdx.x - p9_rem < mem_early)
            mem_item(c, (int)blockIdx.x - p9_rem, (const bf16_t*)(c.ws + O_PROJ), NBI, B_MQ, B_MZ, (const bf16_t*)(c.ws + O_MEMK_B), (const bf16_t*)(c.ws + O_MEMVT_B), (bf16_t*)(c.ws + O_H));
    }
    SEAM(9);
    if (IN(10)) REPS(10) {
        unsigned* ctr = (unsigned*)(c.ws + O_CTL) + rep_;
        LAS unsigned* sh = (LAS unsigned*)(c.lds + LDS_CTL + 16);
        const bf16_t* Qb = (const bf16_t*)(c.ws + O_Q); const bf16_t* Kf = (const bf16_t*)(c.ws + O_KF); const bf16_t* VT = (const bf16_t*)(c.ws + O_VT);
        const bf16_t* projB = (const bf16_t*)(c.ws + O_PROJ); bf16_t* mix = (bf16_t*)(c.ws + O_H);
        for (;;) {
            if (threadIdx.x == 0) *sh = atomicAdd(ctr, 1u);
            __syncthreads();
            const unsigned it = (unsigned)__builtin_amdgcn_readfirstlane((int)*sh);
            __syncthreads();
            if (it >= 768u + 256u - (unsigned)mem_early) break;
            if (it < 768u) {
                const int qb = 15 - (int)(it / 48u), bh = (int)(it % 48u), b = bh / 12, hd = bh % 12;
                const size_t row0 = (size_t)b * SEQ + 256 * qb;
                flash_item<192, true>(c.lds, Qb + row0 * 2304 + hd * 192, 2304, Kf + (size_t)b * SEQ * 2304 + hd * 192, 2304,
                                      VT + (size_t)(hd * 128) * T + (size_t)b * SEQ, T, 256 * (qb + 1), 256 * qb,
                                      projB + row0 * NBI + B_Z + hd * 128, NBI, mix + row0 * 2048 + hd * 128, 2048);
            } else {
                mem_item(c, (int)it - 768 + mem_early, projB, NBI, B_MQ, B_MZ, (const bf16_t*)(c.ws + O_MEMK_B), (const bf16_t*)(c.ws + O_MEMVT_B), mix);
            }
        }
    }
    SEAM(10);
    if (IN(11)) REPS(11) pg8::gemm_phase<9>(c.lds, c.ws, cosT, sinT);
    SEAM(11);
    if (IN(12)) post_rows<false>(c.out, (const bf16_t*)(c.ws + O_ST), c.in(24), c.out, nullptr);
#ifndef GEMM_PROBE
#define GEMM_PROBE 0
#endif
    if (GEMM_PROBE && hi == 13) {
        xcd_barrier(xbar);
        if (GEMM_PROBE & 1) pg8::gemm_phase<1>(c.lds, c.ws, cosT, sinT);
        if (GEMM_PROBE & 2) pg8::gemm_phase<3>(c.lds, c.ws, cosT, sinT);
        if (GEMM_PROBE & 4) pg8::gemm_phase<5>(c.lds, c.ws, cosT, sinT);
        if (GEMM_PROBE & 8) pg8::gemm_phase<7>(c.lds, c.ws, cosT, sinT);
        if (GEMM_PROBE & 16) pg8::gemm_phase<9>(c.lds, c.ws, cosT, sinT);
        if (GEMM_PROBE & 32) gla_scan(c);
        if (GEMM_PROBE & 64) for (int i = 0; i < 20; ++i) xcd_barrier(xbar);
    }
#undef IN
#undef SEAM
}

constexpr int N_PHASES = 13;
#ifndef MK_ONE_LAUNCH
#define MK_ONE_LAUNCH 1
#endif

extern "C" void kernel_launch(void* const* d_in, const int* in_sizes, int n_in, void* d_out, int out_size, void* d_ws, size_t ws_size, hipStream_t stream) {
    static int grid = 0;
    if (grid == 0) {
        if (ws_size < WS_END) { fprintf(stderr, "kernel_launch: workspace too small: %zu < %zu\n", ws_size, (size_t)WS_END); grid = -1; return; }
        int dev = 0, cus = 0, per_cu = 0;
        hipGetDevice(&dev);
        hipDeviceGetAttribute(&cus, hipDeviceAttributeMultiprocessorCount, dev);
        if (hipFuncSetAttribute((const void*)yoco_fwd, hipFuncAttributeMaxDynamicSharedMemorySize, LDS_BYTES) != hipSuccess) { fprintf(stderr, "kernel_launch: hipFuncSetAttribute failed\n"); grid = -1; return; }
        if (hipOccupancyMaxActiveBlocksPerMultiprocessor(&per_cu, (const void*)yoco_fwd, NTHR, LDS_BYTES) != hipSuccess || per_cu < 1) { fprintf(stderr, "kernel_launch: occupancy query gave %d\n", per_cu); per_cu = 1; }
        (void)hipGetLastError();
        grid = cus * 1;
        if (grid <= 0) grid = 256;
    }
    if (grid < 0) return;
    if (hipMemsetAsync((char*)d_ws + O_CTL, 0, CTL_BYTES, stream) != hipSuccess) { fprintf(stderr, "kernel_launch: memset failed\n"); return; }
    Args a{};
    for (int i = 0; i < 25; ++i) a.in[i] = (const float*)d_in[i];
    a.out = (float*)d_out; a.ws = (unsigned char*)d_ws;
#if MK_ONE_LAUNCH
    a.ph_lo = 0; a.ph_hi = N_PHASES;
    void* args[] = {&a};
    hipError_t e = hipLaunchCooperativeKernel((const void*)yoco_fwd, dim3(grid), dim3(NTHR), args, LDS_BYTES, stream);
    if (e != hipSuccess) fprintf(stderr, "cooperative launch failed: %s (grid %d)\n", hipGetErrorString(e), grid);
#else
    for (int p = 0; p < N_PHASES; ++p) {
        a.ph_lo = p; a.ph_hi = p + 1;
        hipLaunchKernelGGL(yoco_fwd, dim3(grid), dim3(NTHR), LDS_BYTES, stream, a);
    }
#endif
}
```

```cpp
#include <hip/hip_runtime.h>
#include <hip/hip_cooperative_groups.h>
#include <cstdio>
namespace cg = cooperative_groups;

#define DI __device__ __forceinline__
#define LAS __attribute__((address_space(3)))
typedef unsigned short bf16_t;
typedef short bf16x8 __attribute__((ext_vector_type(8)));
typedef float f32x4 __attribute__((ext_vector_type(4)));
typedef float f32x2 __attribute__((ext_vector_type(2)));
typedef float f32x16 __attribute__((ext_vector_type(16)));
typedef unsigned u32x4 __attribute__((ext_vector_type(4)));
typedef unsigned u32x2 __attribute__((ext_vector_type(2)));
typedef __bf16 bf16nx2 __attribute__((ext_vector_type(2)));

constexpr int T = 16384, DM = 2048, SEQ = 4096;
constexpr int NTHR = 512;
constexpr int NA = 4352;
constexpr int A_Q = 0, A_K = 768, A_Z = 1536, A_MQ = 3072, A_MZ = 3584, A_G = 4096;
constexpr int NBI = 3840;
constexpr int B_CQ = 0, B_Z = 512, B_MQ = 2048, B_MZ = 2560, B_C = 3072, B_KR = 3584;
constexpr float LOG2E = 1.4426950408889634f;
constexpr float EPS = 1e-6f;

constexpr size_t al256(size_t x) { return (x + 255) & ~(size_t)255; }
constexpr size_t O_CTL = 0;
constexpr size_t CTL_BYTES = 16384;
constexpr size_t O_WA_IN = CTL_BYTES;
constexpr size_t O_WA_V = O_WA_IN + (size_t)NA * 2048 * 2;
constexpr size_t O_WA_OUT = O_WA_V + (size_t)1536 * 2048 * 2;
constexpr size_t O_WMK_A = O_WA_OUT + (size_t)2048 * 2048 * 2;
constexpr size_t O_WMV_A = O_WMK_A + (size_t)512 * 2048 * 2;
constexpr size_t O_WMK_B = O_WMV_A + (size_t)512 * 2048 * 2;
constexpr size_t O_WMV_B = O_WMK_B + (size_t)512 * 2048 * 2;
constexpr size_t O_WB_IN = O_WMV_B + (size_t)512 * 2048 * 2;
constexpr size_t O_WUK = O_WB_IN + (size_t)NBI * 2048 * 2;
constexpr size_t O_WUV = O_WUK + (size_t)1536 * 512 * 2;
constexpr size_t O_WUQ = O_WUV + (size_t)1536 * 512 * 2;
constexpr size_t O_WB_OUT = O_WUQ + (size_t)2304 * 512 * 2;
constexpr size_t O_MEMN = O_WB_OUT + (size_t)2048 * 2048 * 2;
constexpr size_t O_MEMK_A = O_MEMN + (size_t)1024 * 2048 * 2;
constexpr size_t O_MEMVT_A = O_MEMK_A + (size_t)1024 * 512 * 2;
constexpr size_t O_MEMK_B = O_MEMVT_A + (size_t)1024 * 512 * 2;
constexpr size_t O_MEMVT_B = O_MEMK_B + (size_t)1024 * 512 * 2;
constexpr size_t O_COS = O_MEMVT_B + (size_t)1024 * 512 * 2;
constexpr size_t O_SIN = O_COS + (size_t)T * 32 * 4;
constexpr size_t O_DVEC = O_SIN + (size_t)T * 32 * 4;
constexpr size_t O_H = O_DVEC + (size_t)1024 * 192 * 4;
constexpr size_t O_PROJ = O_H + (size_t)T * 2048 * 2;
constexpr size_t O_VT = O_PROJ + (size_t)T * NA * 2;
constexpr size_t O_ST = O_VT + (size_t)1536 * T * 2;
constexpr size_t O_Q = O_ST;
constexpr size_t O_KF = O_ST + (size_t)T * 2304 * 2;
constexpr size_t O_CN = O_ST + (size_t)1024 * 73728 * 2;
constexpr size_t O_CQN = O_CN + (size_t)T * 512 * 2;
constexpr size_t WS_END = O_CQN + (size_t)T * 512 * 2;
static_assert(WS_END <= (size_t)536870912, "workspace");
static_assert((size_t)T * 2304 * 2 * 2 <= (size_t)1024 * 73728 * 2, "Q+K fit");

DI float bf2f(bf16_t b) { return __uint_as_float(((unsigned)b) << 16); }
DI float bflo(unsigned u) { return __uint_as_float(u << 16); }
DI float bfhi(unsigned u) { return __uint_as_float(u & 0xffff0000u); }
DI unsigned pk2(float lo, float hi) { f32x2 v = {lo, hi}; bf16nx2 r = __builtin_convertvector(v, bf16nx2); return __builtin_bit_cast(unsigned, r); }
DI bf16_t f2bf(float x) { return (bf16_t)(pk2(x, 0.f) & 0xffffu); }
DI f32x4 ldnt_f4(const float* p) { return __builtin_nontemporal_load((const f32x4*)p); }
DI u32x2 ldnt_u2(const void* p) { return __builtin_nontemporal_load((const u32x2*)p); }
DI u32x4 ldnt_u4(const void* p) { return __builtin_nontemporal_load((const u32x4*)p); }
DI void stnt_f4(float* p, f32x4 v) { __builtin_nontemporal_store(v, (f32x4*)p); }
DI void stnt_u2(void* p, u32x2 v) { __builtin_nontemporal_store(v, (u32x2*)p); }
DI float wave_sum(float v) {
#pragma unroll
    for (int o = 32; o >= 1; o >>= 1) v += __shfl_xor(v, o, 64);
    return v;
}
DI float silu(float z) { return z / (1.f + __expf(-z)); }
DI int tokperm16(int p) { const int g = (p >> 2) & 3; const int g2 = (g == 1) ? 2 : (g == 2 ? 1 : g); return (p & ~12) | (g2 << 2); }

typedef const __attribute__((address_space(4))) unsigned char* kargp_t;
struct Ctx {
    kargp_t ka; float* out; unsigned char* ws; LAS unsigned char* lds;
    DI const float* in(int i) const { return *(const float* const __attribute__((address_space(4)))*)(ka + 8 * i); }
};

struct ConvJob { const float* src; const float* src2; const float* gain; const float* gain2; bf16_t* dst; int ldsrc, ldsrc2, K, rows, kind; };
DI ConvJob conv_job(const Ctx& c, int j) {
    ConvJob J; J.src2 = nullptr; J.gain2 = nullptr; J.ldsrc2 = 0;
    unsigned char* ws = c.ws;
    switch (j) {
    case 0: J = ConvJob{c.in(4), nullptr, c.in(3), nullptr, (bf16_t*)(ws + O_WA_IN), 5648, 0, 2048, NA, 0}; break;
    case 1: J = ConvJob{c.in(4), nullptr, c.in(3), nullptr, (bf16_t*)(ws + O_WA_V), 5648, 0, 2048, 1536, 1}; break;
    case 2: J = ConvJob{c.in(10), nullptr, nullptr, nullptr, (bf16_t*)(ws + O_WA_OUT), 2048, 0, 2048, 2048, 2}; break;
    case 3: J = ConvJob{c.in(9), nullptr, c.in(8), nullptr, (bf16_t*)(ws + O_WMK_A), 1024, 0, 2048, 512, 2}; break;
    case 4: J = ConvJob{c.in(9) + 512, nullptr, c.in(8), nullptr, (bf16_t*)(ws + O_WMV_A), 1024, 0, 2048, 512, 2}; break;
    case 5: J = ConvJob{c.in(22), nullptr, c.in(21), nullptr, (bf16_t*)(ws + O_WMK_B), 1024, 0, 2048, 512, 2}; break;
    case 6: J = ConvJob{c.in(22) + 512, nullptr, c.in(21), nullptr, (bf16_t*)(ws + O_WMV_B), 1024, 0, 2048, 512, 2}; break;
    case 7: J = ConvJob{c.in(18), c.in(13), c.in(17), c.in(12), (bf16_t*)(ws + O_WB_IN), 3072, 576, 2048, NBI, 3}; break;
    case 8: J = ConvJob{c.in(15), nullptr, c.in(14), nullptr, (bf16_t*)(ws + O_WUK), 1536, 0, 512, 1536, 2}; break;
    case 9: J = ConvJob{c.in(16), nullptr, c.in(14), nullptr, (bf16_t*)(ws + O_WUV), 1536, 0, 512, 1536, 2}; break;
    case 10: J = ConvJob{c.in(20), nullptr, c.in(19), nullptr, (bf16_t*)(ws + O_WUQ), 2304, 0, 512, 2304, 4}; break;
    default: J = ConvJob{c.in(23), nullptr, nullptr, nullptr, (bf16_t*)(ws + O_WB_OUT), 2048, 0, 2048, 2048, 2}; break;
    }
    return J;
}
constexpr int N_CONV_JOBS = 12;
DI int conv_tiles(int j) {
    switch (j) {
    case 0: return (NA / 64) * 16; case 1: return 24 * 16; case 2: return 32 * 16;
    case 3: case 4: case 5: case 6: return 8 * 16;
    case 7: return (NBI / 64) * 16; case 8: case 9: return 24 * 4; case 10: return 36 * 4; default: return 32 * 16;
    }
}
DI void conv_map(int kind, int n, int& col, float& scale, int& which) {
    which = 0; scale = 1.f; col = n;
    if (kind == 0) {
        if (n < 768) { col = n; scale = 0.07216878364870322f; }
        else if (n < 1536) col = n;
        else if (n < 3072) col = 3088 + (n - 1536);
        else if (n < 3584) { col = 4624 + (n - 3072); scale = 0.08838834764831845f * LOG2E; }
        else if (n < 4096) col = 5136 + (n - 3584);
        else if (n < 4112) col = 3072 + (n - 4096);
        else col = -1;
    } else if (kind == 1) { col = 1536 + n; }
    else if (kind == 3) {
        if (n < 3072) { col = n; if (n >= 2048 && n < 2560) scale = 0.08838834764831845f * LOG2E; }
        else if (n < 3648) { col = n - 3072; which = 1; }
        else col = -1;
    } else if (kind == 4) {
        scale = 0.07216878364870322f * LOG2E;
        const int hd = n / 192, off = n % 192;
        if (off < 128) col = n;
        else { const int p = off - 128, g = p >> 3, e = p & 7; col = hd * 192 + 128 + (e < 4 ? 4 * g + e : 32 + 4 * g + (e - 4)); }
    }
}
struct ConvRegs { f32x4 v[4]; float g[4]; };
DI void conv_load(const ConvJob& J, int tile, ConvRegs& R) {
    const int tid = threadIdx.x, ktiles = J.K / 128;
    const int n0 = (tile / ktiles) * 64, k0 = (tile % ktiles) * 128, nq = (tid & 15) * 4, kq = tid >> 4;
    int col, which; float scale; conv_map(J.kind, n0 + nq, col, scale, which);
    const float* src = which ? J.src2 : J.src; const int ld = which ? J.ldsrc2 : J.ldsrc; const float* gain = which ? J.gain2 : J.gain;
#pragma unroll
    for (int i = 0; i < 4; ++i) { const int k = k0 + kq + 32 * i; R.v[i] = (col >= 0) ? ldnt_f4(src + (size_t)k * ld + col) : (f32x4){0.f, 0.f, 0.f, 0.f}; R.g[i] = (gain ? gain[k] : 1.f) * scale; }
}
DI void conv_store(const Ctx& c, const ConvJob& J, int tile, const ConvRegs& R) {
    const int tid = threadIdx.x, ktiles = J.K / 128;
    const int n0 = (tile / ktiles) * 64, k0 = (tile % ktiles) * 128, nq = (tid & 15) * 4, kq = tid >> 4;
    LAS bf16_t* sm = (LAS bf16_t*)c.lds;
#pragma unroll
    for (int i = 0; i < 4; ++i)
#pragma unroll
        for (int e = 0; e < 4; ++e) sm[(nq + e) * 136 + kq + 32 * i] = f2bf(R.v[i][e] * R.g[i]);
    __syncthreads();
#pragma unroll
    for (int i = 0; i < 2; ++i) { const int id = tid + 512 * i, row = id >> 4, ck = id & 15;
        const u32x4 w = *(const LAS u32x4*)(sm + row * 136 + ck * 8);
        *(u32x4*)(J.dst + (size_t)(n0 + row) * J.K + k0 + ck * 8) = w; }
    __syncthreads();
}
DI void conv_tiles_strided(const Ctx& c, const ConvJob& J, int first, int nt, int stride) {
    if (first >= nt) return;
    ConvRegs R; conv_load(J, first, R);
    for (int t = first; t < nt; t += stride) {
        const ConvRegs Rc = R;
        if (t + stride < nt) conv_load(J, t + stride, R);
        conv_store(c, J, t, Rc);
    }
}
DI void norm_rows_f32(const float* src, bf16_t* dst, int nrows) {
    const int lane = threadIdx.x & 63, wv = threadIdx.x >> 6;
    for (int r = blockIdx.x * 8 + wv; r < nrows; r += gridDim.x * 8) {
        const float* p = src + (size_t)r * 2048;
        f32x4 a[8]; float ss = 0.f;
#pragma unroll
        for (int i = 0; i < 8; ++i) { a[i] = ldnt_f4(p + 4 * lane + 256 * i); ss += a[i][0] * a[i][0] + a[i][1] * a[i][1] + a[i][2] * a[i][2] + a[i][3] * a[i][3]; }
        ss = wave_sum(ss); const float rr = rsqrtf(ss * (1.f / 2048.f) + EPS);
#pragma unroll
        for (int i = 0; i < 8; ++i) { u32x2 w; w[0] = pk2(a[i][0] * rr, a[i][1] * rr); w[1] = pk2(a[i][2] * rr, a[i][3] * rr);
            *(u32x2*)(dst + (size_t)r * 2048 + 4 * lane + 256 * i) = w; }
    }
}
DI bool conv_deferred(int j) { return j == 2 || j == 8 || j == 9 || j == 10 || j == 11; }
DI void conv_fill(const Ctx& c, int units, int j_lo, int j_hi) {
    const int G = gridDim.x, r = units % G;
    int nidle = (r == 0) ? G : G - r, me = (r == 0) ? (int)blockIdx.x : (int)blockIdx.x - r;
    if (me < 0) return;
    int base = 0;
    for (int j = j_lo; j <= j_hi; ++j) {
        if (!conv_deferred(j)) continue;
        const int nt = conv_tiles(j); const ConvJob J = conv_job(c, j);
        int first = me - (base % nidle); if (first < 0) first += nidle;
        conv_tiles_strided(c, J, first, nt, nidle);
        base += nt;
    }
}
DI void phase0(const Ctx& c) {
    int base = 0;
    for (int j = 0; j < N_CONV_JOBS; ++j) {
        if (conv_deferred(j)) continue;
        const int nt = conv_tiles(j); const ConvJob J = conv_job(c, j);
        int first = (int)blockIdx.x - (base % (int)gridDim.x); if (first < 0) first += gridDim.x;
        conv_tiles_strided(c, J, first, nt, gridDim.x);
        base += nt;
    }
    norm_rows_f32(c.in(0), (bf16_t*)(c.ws + O_H), T);
    norm_rows_f32(c.in(1), (bf16_t*)(c.ws + O_MEMN), 1024);
}

namespace pg8 {
constexpr int BM = 256, BK = 64, HALF = 128, HTB = HALF * BK * 2, STAGE_BYTES = 8 * HTB, NXCD = 8, WGM = 8;
DI int lds_byte(int r, int c) { const int st = (r >> 4) * 2 + (c >> 5), rr = r & 15, cc = c & 31, ob = rr * 64 + cc * 2; return st * 1024 + (ob ^ (((ob >> 9) & 1) << 5)); }
DI void stage_rc(int b, int& R, int& C) { const int st = b / 1024, sb = b % 1024, swz = sb ^ (((sb >> 9) & 1) << 5); R = (st >> 1) * 16 + swz / 64; C = (st & 1) * 32 + (swz % 64) / 2; }
DI int perm32(int rho) { const int n = rho >> 4, i = rho & 15; return 8 * (i >> 2) + 4 * n + (i & 3); }
DI int permT(int rho) { const int n = rho >> 4, i = rho & 15, fq = i >> 2, j = i & 3; return 16 * (fq >> 1) + 4 * ((fq & 1) + 2 * n) + j; }

struct Unit { int pm, pn, gid; };
struct GDesc { const bf16_t* A; const bf16_t* Bt; bf16_t* C; int nM, nN, ldc, mode; };

template <int PH> DI int n_gemms();
template <int PH> DI GDesc gdesc(unsigned char* ws, int gid);
template <int PH> struct PhK;

template <> struct PhK<1> { static constexpr int K = 2048; };
template <> DI int n_gemms<1>() { return 6; }
template <> DI GDesc gdesc<1>(unsigned char* ws, int gid) {
    switch (gid) {
    case 0: return GDesc{(const bf16_t*)(ws + O_H), (const bf16_t*)(ws + O_WA_IN), (bf16_t*)(ws + O_PROJ), 64, 17, NA, 0};
    case 1: return GDesc{(const bf16_t*)(ws + O_WA_V), (const bf16_t*)(ws + O_H), (bf16_t*)(ws + O_VT), 6, 64, T, 1 | 32};
    case 2: return GDesc{(const bf16_t*)(ws + O_MEMN), (const bf16_t*)(ws + O_WMK_A), (bf16_t*)(ws + O_MEMK_A), 4, 2, 512, 0};
    case 3: return GDesc{(const bf16_t*)(ws + O_WMV_A), (const bf16_t*)(ws + O_MEMN), (bf16_t*)(ws + O_MEMVT_A), 2, 4, 1024, 1};
    case 4: return GDesc{(const bf16_t*)(ws + O_MEMN), (const bf16_t*)(ws + O_WMK_B), (bf16_t*)(ws + O_MEMK_B), 4, 2, 512, 0};
    default: return GDesc{(const bf16_t*)(ws + O_WMV_B), (const bf16_t*)(ws + O_MEMN), (bf16_t*)(ws + O_MEMVT_B), 2, 4, 1024, 1};
    }
}
template <> struct PhK<3> { static constexpr int K = 2048; };
template <> DI int n_gemms<3>() { return 1; }
template <> DI GDesc gdesc<3>(unsigned char* ws, int) { return GDesc{(const bf16_t*)(ws + O_H), (const bf16_t*)(ws + O_WA_OUT), (bf16_t*)(ws + O_PROJ), 64, 8, 2048, 0}; }
template <> struct PhK<5> { static constexpr int K = 2048; };
template <> DI int n_gemms<5>() { return 1; }
template <> DI GDesc gdesc<5>(unsigned char* ws, int) { return GDesc{(const bf16_t*)(ws + O_H), (const bf16_t*)(ws + O_WB_IN), (bf16_t*)(ws + O_PROJ), 64, 15, NBI, 0}; }
template <> struct PhK<7> { static constexpr int K = 512; };
template <> DI int n_gemms<7>() { return 3; }
template <> DI GDesc gdesc<7>(unsigned char* ws, int gid) {
    switch (gid) {
    case 0: return GDesc{(const bf16_t*)(ws + O_CQN), (const bf16_t*)(ws + O_WUQ), (bf16_t*)(ws + O_Q), 64, 9, 2304, 4};
    case 1: return GDesc{(const bf16_t*)(ws + O_CN), (const bf16_t*)(ws + O_WUK), (bf16_t*)(ws + O_KF), 64, 6, 2304, 2};
    default: return GDesc{(const bf16_t*)(ws + O_WUV), (const bf16_t*)(ws + O_CN), (bf16_t*)(ws + O_VT), 6, 64, T, 1};
    }
}
template <> struct PhK<9> { static constexpr int K = 2048; };
template <> DI int n_gemms<9>() { return 1; }
template <> DI GDesc gdesc<9>(unsigned char* ws, int) { return GDesc{(const bf16_t*)(ws + O_H), (const bf16_t*)(ws + O_WB_OUT), (bf16_t*)(ws + O_ST), 64, 8, 2048, 0}; }

template <int PH> DI bool next_unit(unsigned char* ws, int i, int G, int c, Unit& u, GDesc& g) {
    long L = (long)i * G + c;
    const int ng = n_gemms<PH>();
    bool found = false;
#pragma unroll
    for (int gid = 0; gid < 6; ++gid) {
        if (gid < ng && !found) {
            const GDesc d = gdesc<PH>(ws, gid); const int nwg = d.nM * d.nN;
            if (L < nwg) {
                int wgid = (int)L; const int nM = d.nM, nN = d.nN;
                { const int q = nwg / NXCD, r = nwg % NXCD, xcd = wgid % NXCD, off = wgid / NXCD; wgid = (xcd < r ? xcd * (q + 1) : r * (q + 1) + (xcd - r) * q) + off; }
                const int nig = WGM * nN, grp = wgid / nig, fm = grp * WGM, gsz = (nM - fm) < WGM ? (nM - fm) : WGM;
                u.pm = fm + ((wgid % nig) % gsz); u.pn = (wgid % nig) / gsz; u.gid = gid; g = d; found = true;
            } else L -= nwg;
        }
    }
    return found;
}

DI void epilogue(const f32x4 (&acc)[2][2][4][2], const Unit& u, const GDesc& g, const float* cosT, const float* sinT, int wr, int wc, int fr, int fq) {
    const int row0 = u.pm * BM + wr * 64 + fr;
#pragma unroll
    for (int bj = 0; bj < 2; ++bj) {
        const int c8 = u.pn * BM + bj * HALF + wc * 32 + 8 * fq;
        int dcol = c8; bool rope = false; int fg = 0;
        if (g.mode & 2) dcol = (c8 >> 7) * 192 + (c8 & 127);
        if (g.mode & 4) { const int off = c8 % 192; if (off >= 128) { rope = true; fg = (off - 128) >> 3; } }
#pragma unroll
        for (int ai = 0; ai < 2; ++ai)
#pragma unroll
            for (int m = 0; m < 4; ++m) {
                const int row = row0 + ai * HALF + m * 16;
                f32x4 v0 = acc[ai][bj][m][0], v1 = acc[ai][bj][m][1];
                if (rope) {
                    const f32x4 cs = *(const f32x4*)(cosT + (size_t)row * 32 + 4 * fg), sn = *(const f32x4*)(sinT + (size_t)row * 32 + 4 * fg);
                    const f32x4 a = v0 * cs - v1 * sn, b = v1 * cs + v0 * sn; v0 = a; v1 = b;
                }
                u32x4 w; w[0] = pk2(v0[0], v0[1]); w[1] = pk2(v0[2], v0[3]); w[2] = pk2(v1[0], v1[1]); w[3] = pk2(v1[2], v1[3]);
                if (g.mode & 32) {
                    const int p = c8 & 63;
                    *(u32x4*)(g.C + ((((size_t)(row >> 5) * (T / 64) + (c8 >> 6)) * 4 + (p >> 4)) * 64 + (row & 31) + 32 * ((p >> 3) & 1)) * 8) = w;
                } else *(u32x4*)(g.C + (size_t)row * g.ldc + dcol) = w;
            }
    }
}

template <int PH>
DI void gemm_phase(LAS unsigned char* lds, unsigned char* ws, const float* cosT, const float* sinT) {
    constexpr int K = PhK<PH>::K, nt = K / BK;
    const int G = gridDim.x, cidx = blockIdx.x;
    const int tid = threadIdx.x, wid = __builtin_amdgcn_readfirstlane(tid >> 6), lane = tid & 63, wr = wid >> 2, wc = wid & 3, fr = lane & 15, fq = lane >> 4;
    unsigned voffA[2], voffB1[2], voffB2[2];
#pragma unroll
    for (int i = 0; i < 2; ++i) { int R, C; stage_rc(tid * 16 + i * 8192, R, C);
        const int Rb1 = (R & ~31) + perm32(R & 31), Rb2 = (R & ~31) + permT(R & 31);
        voffA[i] = (unsigned)(R * K + C) * 2u; voffB1[i] = (unsigned)(Rb1 * K + C) * 2u; voffB2[i] = (unsigned)(Rb2 * K + C) * 2u; }
    const size_t kstep = (size_t)(BK * 2);
    const size_t hstep = (size_t)HALF * K * 2;
    const size_t tstep = 2 * hstep;
    const unsigned ldsw = (unsigned)wid * 1024u;
    const int aoff = lds_byte(wr * 64 + fr, fq * 8), boff = lds_byte(wc * 32 + fr, fq * 8);
#define PG8_SA(b, h) (((b) * 2 + (h)) * HTB)
#define PG8_SB(b, h) ((4 + (b) * 2 + (h)) * HTB)
#define PG8_STAGE(bufoff, gbase, v0, v1) do { \
        __builtin_amdgcn_global_load_lds((const unsigned*)((const char*)(gbase) + (v0)), (LAS unsigned*)(lds + (bufoff) + ldsw), 16, 0, 0); \
        __builtin_amdgcn_global_load_lds((const unsigned*)((const char*)(gbase) + (v1)), (LAS unsigned*)(lds + (bufoff) + ldsw + 8192), 16, 0, 0); } while (0)
#define PG8_LDA(dst, b, h) do { _Pragma("unroll") for (int m = 0; m < 4; ++m) _Pragma("unroll") for (int k = 0; k < 2; ++k) dst[m][k] = *(const LAS bf16x8*)(lds + PG8_SA(b, h) + aoff + m * 2048 + k * 1024); } while (0)
#define PG8_LDB(dst, b, h) do { _Pragma("unroll") for (int n = 0; n < 2; ++n) _Pragma("unroll") for (int k = 0; k < 2; ++k) dst[n][k] = *(const LAS bf16x8*)(lds + PG8_SB(b, h) + boff + n * 2048 + k * 1024); } while (0)
#define PG8_MMA(ai, bj, At, Bt) do { __builtin_amdgcn_s_setprio(1); _Pragma("unroll") for (int m = 0; m < 4; ++m) _Pragma("unroll") for (int n = 0; n < 2; ++n) _Pragma("unroll") for (int k = 0; k < 2; ++k) \
        acc[ai][bj][m][n] = __builtin_amdgcn_mfma_f32_16x16x32_bf16(Bt[n][k], At[m][k], acc[ai][bj][m][n], 0, 0, 0); __builtin_amdgcn_s_setprio(0); } while (0)
#define PG8_WAIT_V(n) asm volatile("s_waitcnt vmcnt(" #n ")" ::: "memory")
#define PG8_WAIT_L(n) asm volatile("s_waitcnt lgkmcnt(" #n ")" ::: "memory")
#define PG8_BAR __builtin_amdgcn_s_barrier()
#define PG8_SCHED __builtin_amdgcn_sched_barrier(0)
    Unit cur, nxt; GDesc gc, gn; int ui = 0;
    if (!next_unit<PH>(ws, 0, G, cidx, cur, gc)) return;
    f32x4 acc[2][2][4][2];
#pragma unroll
    for (int a = 0; a < 2; ++a)
#pragma unroll
        for (int b = 0; b < 2; ++b)
#pragma unroll
            for (int m = 0; m < 4; ++m)
#pragma unroll
                for (int n = 0; n < 2; ++n) acc[a][b][m][n] = (f32x4){0.f, 0.f, 0.f, 0.f};
    bf16x8 At[4][2], B0[2][2], B1[2][2];
    const char* cA = (const char*)gc.A + (size_t)cur.pm * tstep; const char* cB = (const char*)gc.Bt + (size_t)cur.pn * tstep;
    unsigned vbc0 = (gc.mode & 1) ? voffB2[0] : voffB1[0], vbc1 = (gc.mode & 1) ? voffB2[1] : voffB1[1];
    const unsigned va0 = voffA[0], va1 = voffA[1];
    PG8_STAGE(PG8_SB(0, 0), cB, vbc0, vbc1); PG8_STAGE(PG8_SA(0, 0), cA, va0, va1); PG8_STAGE(PG8_SB(0, 1), cB + hstep, vbc0, vbc1); PG8_STAGE(PG8_SA(0, 1), cA + hstep, va0, va1);
    if (wr == 1) PG8_BAR;
    PG8_WAIT_V(4); PG8_BAR;
    PG8_STAGE(PG8_SB(1, 0), cB + kstep, vbc0, vbc1); PG8_STAGE(PG8_SA(1, 0), cA + kstep, va0, va1); PG8_STAGE(PG8_SB(1, 1), cB + hstep + kstep, vbc0, vbc1);
    PG8_WAIT_V(6); PG8_BAR;
    for (;;) {
        const bool has_next = next_unit<PH>(ws, ui + 1, G, cidx, nxt, gn);
        const char* nA = has_next ? (const char*)gn.A + (size_t)nxt.pm * tstep : cA; const char* nB = has_next ? (const char*)gn.Bt + (size_t)nxt.pn * tstep : cB;
        const unsigned vbn0 = has_next ? ((gn.mode & 1) ? voffB2[0] : voffB1[0]) : vbc0, vbn1 = has_next ? ((gn.mode & 1) ? voffB2[1] : voffB1[1]) : vbc1;
        for (int t = 0; t < nt; t += 2) {
            const bool last = (t == nt - 2);
            const char* a1 = cA + (size_t)(t + 1) * kstep;
            const char* a2 = last ? nA : cA + (size_t)(t + 2) * kstep; const char* b2 = last ? nB : cB + (size_t)(t + 2) * kstep;
            const char* a3 = a2 + kstep; const char* b3 = b2 + kstep;
            const unsigned vb0 = last ? vbn0 : vbc0, vb1 = last ? vbn1 : vbc1;
            PG8_LDB(B0, 0, 0); PG8_SCHED; PG8_LDA(At, 0, 0); PG8_STAGE(PG8_SA(1, 1), a1 + hstep, va0, va1);
            PG8_WAIT_L(8); PG8_BAR; PG8_WAIT_L(0); PG8_MMA(0, 0, At, B0); PG8_BAR; PG8_SCHED;
            PG8_LDB(B1, 0, 1); PG8_STAGE(PG8_SB(0, 0), b2, vb0, vb1);
            PG8_BAR; PG8_WAIT_L(0); PG8_MMA(0, 1, At, B1); PG8_BAR;
            PG8_LDA(At, 0, 1); PG8_STAGE(PG8_SA(0, 0), a2, va0, va1);
            PG8_BAR; PG8_WAIT_L(0); PG8_MMA(1, 0, At, B0); PG8_BAR; PG8_SCHED;
            PG8_STAGE(PG8_SB(0, 1), b2 + hstep, vb0, vb1);
            PG8_WAIT_V(6); PG8_BAR; PG8_MMA(1, 1, At, B1); PG8_BAR;
            PG8_LDB(B0, 1, 0); PG8_SCHED; PG8_LDA(At, 1, 0); PG8_STAGE(PG8_SA(0, 1), a2 + hstep, va0, va1);
            PG8_WAIT_L(8); PG8_BAR; PG8_WAIT_L(0); PG8_MMA(0, 0, At, B0); PG8_BAR; PG8_SCHED;
            PG8_LDB(B1, 1, 1); PG8_STAGE(PG8_SB(1, 0), b3, vb0, vb1);
            PG8_BAR; PG8_WAIT_L(0); PG8_MMA(0, 1, At, B1); PG8_BAR;
            PG8_LDA(At, 1, 1); PG8_STAGE(PG8_SA(1, 0), a3, va0, va1);
            PG8_BAR; PG8_WAIT_L(0); PG8_MMA(1, 0, At, B0); PG8_BAR; PG8_SCHED;
            PG8_STAGE(PG8_SB(1, 1), b3 + hstep, vb0, vb1);
            PG8_WAIT_V(6); PG8_BAR; PG8_MMA(1, 1, At, B1); PG8_BAR;
        }
        epilogue(acc, cur, gc, cosT, sinT, wr, wc, fr, fq);
        if (!has_next) break;
#pragma unroll
        for (int a = 0; a < 2; ++a)
#pragma unroll
            for (int b = 0; b < 2; ++b)
#pragma unroll
                for (int m = 0; m < 4; ++m)
#pragma unroll
                    for (int n = 0; n < 2; ++n) acc[a][b][m][n] = (f32x4){0.f, 0.f, 0.f, 0.f};
        cur = nxt; gc = gn; cA = nA; cB = nB; vbc0 = vbn0; vbc1 = vbn1; ++ui;
    }
    PG8_WAIT_V(0);
    if (wr == 0) PG8_BAR;
    PG8_BAR;
#undef PG8_SA
#undef PG8_SB
#undef PG8_STAGE
#undef PG8_LDA
#undef PG8_LDB
#undef PG8_MMA
#undef PG8_WAIT_V
#undef PG8_WAIT_L
#undef PG8_BAR
#undef PG8_SCHED
}
}

#define MFMA32(a, b, c) __builtin_amdgcn_mfma_f32_32x32x16_bf16((a), (b), (c), 0, 0, 0)
constexpr int FL_KSTR = 400, FL_VSTR = 144, FL_KBUF = 64 * FL_KSTR, FL_VBUF = 128 * FL_VSTR;
template <int DQK, bool CAUSAL>
DI void flash_item(LAS unsigned char* lds, const bf16_t* Q, int ldq, const bf16_t* Kp, int ldk, const bf16_t* VT, int ldv,
                   int nkeys, int q0, const bf16_t* gate, int ldg, bf16_t* out, int ldo) {
    constexpr int NKS = DQK / 16;
    constexpr int KSTR = DQK * 2 + 16;
    const int tid = threadIdx.x, w = __builtin_amdgcn_readfirstlane(tid >> 6), lane = tid & 63, ql = lane & 31, h = lane >> 5;
    bf16x8 qf[NKS];
#pragma unroll
    for (int ks = 0; ks < NKS; ++ks) qf[ks] = *(const bf16x8*)(Q + (size_t)(32 * w + ql) * ldq + 16 * ks + 8 * h);
    f32x16 O[4];
#pragma unroll
    for (int i = 0; i < 4; ++i)
#pragma unroll
        for (int j = 0; j < 16; ++j) O[i][j] = 0.f;
    float mrun = -INFINITY, lsum = 0.f;
    const int nt = nkeys / 64;
    const int qmin = q0 + 32 * w, qmax = qmin + 31;
    constexpr int KCHUNKS = (64 * KSTR + 1023) / 1024, VCHUNKS = (128 * FL_VSTR + 1023) / 1024;
    constexpr int KPW = (KCHUNKS + 7) / 8, VPW = (VCHUNKS + 7) / 8;
    unsigned koff[KPW], voff[VPW];
#pragma unroll
    for (int i = 0; i < KPW; ++i) { const int o = (w + 8 * i) * 1024 + lane * 16; int r = o / KSTR, wi = o % KSTR; if (r > 63) r = 63; if (wi >= DQK * 2) wi = 0; koff[i] = (unsigned)(r * ldk * 2 + wi); }
#pragma unroll
    for (int i = 0; i < VPW; ++i) { const int o = (w + 8 * i) * 1024 + lane * 16; int d = o / FL_VSTR, wi = o % FL_VSTR; if (d > 127) d = 127; if (wi >= 128) wi = 0; voff[i] = (unsigned)(d * ldv * 2 + wi); }
#define FL_ISSUE(t, kbuf_, vbuf_) do { const char* kb_ = (const char*)(Kp + (size_t)(t) * 64 * ldk); const char* vb_ = (const char*)(VT + (size_t)(t) * 64); \
        _Pragma("unroll") for (int i = 0; i < KPW; ++i) if (w + 8 * i < KCHUNKS) __builtin_amdgcn_global_load_lds((const unsigned*)(kb_ + koff[i]), (LAS unsigned*)(lds + (kbuf_) * FL_KBUF + (w + 8 * i) * 1024), 16, 0, 0); \
        _Pragma("unroll") for (int i = 0; i < VPW; ++i) if (w + 8 * i < VCHUNKS) __builtin_amdgcn_global_load_lds((const unsigned*)(vb_ + voff[i]), (LAS unsigned*)(lds + 2 * FL_KBUF + (vbuf_) * FL_VBUF + (w + 8 * i) * 1024), 16, 0, 0); } while (0)
#define FL_PV(vbuf_) do { _Pragma("unroll") for (int b = 0; b < 4; ++b) { __builtin_amdgcn_sched_barrier(0); \
        _Pragma("unroll") for (int dt = 0; dt < 4; ++dt) { \
            const bf16x8 vf = *(const LAS bf16x8*)(lds + 2 * FL_KBUF + (vbuf_) * FL_VBUF + (32 * dt + ql) * FL_VSTR + (16 * b + 8 * h) * 2); \
            O[dt] = MFMA32(vf, pf[b], O[dt]); } } } while (0)
    const bool late = (w >= 4);
    bf16x8 pf[4];
#pragma unroll
    for (int b = 0; b < 4; ++b) pf[b] = (bf16x8){0, 0, 0, 0, 0, 0, 0, 0};
    int havep = 0, vb = 0, vprev = 0;
    FL_ISSUE(0, 0, 0);
    for (int t = 0; t < nt; ++t) {
        const int buf = t & 1;
        asm volatile("s_waitcnt vmcnt(0)" ::: "memory");
        __syncthreads();
        const int vnext = (vb == 2) ? 0 : vb + 1;
        if (t + 1 < nt) FL_ISSUE(t + 1, buf ^ 1, vnext);
        if (late && havep) { FL_PV(vprev); havep = 0; }
        const int k0 = t * 64;
        if (!CAUSAL || k0 <= qmax) {
            const float sinit = (t == 0) ? 0.f : -mrun;
            f32x16 S[2];
#pragma unroll
            for (int mt = 0; mt < 2; ++mt) {
                __builtin_amdgcn_sched_barrier(0);
#pragma unroll
                for (int j = 0; j < 16; ++j) S[mt][j] = sinit;
#pragma unroll
                for (int ks = 0; ks < NKS; ++ks) {
                    const bf16x8 kf = *(const LAS bf16x8*)(lds + buf * FL_KBUF + (32 * mt + ql) * KSTR + (16 * ks + 8 * h) * 2);
                    S[mt] = MFMA32(kf, qf[ks], S[mt]);
                }
            }
            if (CAUSAL && k0 + 63 > qmin) {
                const int q = qmin + ql;
#pragma unroll
                for (int mt = 0; mt < 2; ++mt)
#pragma unroll
                    for (int j = 0; j < 16; ++j) { const int key = k0 + 32 * mt + 8 * (j >> 2) + 4 * h + (j & 3); if (key > q) S[mt][j] = -INFINITY; }
            }
            float mx = fmaxf(fmaxf(S[0][0], S[0][1]), S[0][2]);
#pragma unroll
            for (int j = 3; j < 15; j += 2) mx = fmaxf(fmaxf(mx, S[0][j]), S[0][j + 1]);
            mx = fmaxf(mx, S[0][15]);
#pragma unroll
            for (int j = 0; j < 16; j += 2) mx = fmaxf(fmaxf(mx, S[1][j]), S[1][j + 1]);
            mx = fmaxf(mx, __shfl_xor(mx, 32, 64));
            if (t == 0 || __builtin_amdgcn_ballot_w64(mx > 8.f) != 0ull) {
                const float delta = (t == 0) ? mx : fmaxf(mx, 0.f);
                const float alpha = __builtin_amdgcn_exp2f(-delta);
                mrun = (t == 0) ? mx : mrun + delta; lsum *= alpha;
#pragma unroll
                for (int mt = 0; mt < 2; ++mt)
#pragma unroll
                    for (int j = 0; j < 16; ++j) S[mt][j] -= delta;
#pragma unroll
                for (int i = 0; i < 4; ++i)
#pragma unroll
                    for (int j = 0; j < 16; ++j) O[i][j] *= alpha;
            }
            f32x2 ps2 = {0.f, 0.f};
#pragma unroll
            for (int mt = 0; mt < 2; ++mt)
#pragma unroll
                for (int j = 0; j < 16; j += 2) { const float p0 = __builtin_amdgcn_exp2f(S[mt][j]), p1 = __builtin_amdgcn_exp2f(S[mt][j + 1]); S[mt][j] = p0; S[mt][j + 1] = p1; ps2 += (f32x2){p0, p1}; }
            lsum += ps2[0] + ps2[1];
#pragma unroll
            for (int b = 0; b < 4; ++b) {
                const int mt = b >> 1, e0 = 8 * (b & 1);
                u32x4 pw; pw[0] = pk2(S[mt][e0], S[mt][e0 + 1]); pw[1] = pk2(S[mt][e0 + 2], S[mt][e0 + 3]); pw[2] = pk2(S[mt][e0 + 4], S[mt][e0 + 5]); pw[3] = pk2(S[mt][e0 + 6], S[mt][e0 + 7]);
                pf[b] = __builtin_bit_cast(bf16x8, pw);
            }
            havep = 1;
            if (!late) { FL_PV(vb); havep = 0; }
        }
        vprev = vb; vb = vnext;
    }
    if (late && havep) { FL_PV(vprev); }
#undef FL_PV
#undef FL_ISSUE
    const float ltot = lsum + __shfl_xor(lsum, 32, 64);
    const float inv = 1.f / ltot;
    __syncthreads();
    LAS unsigned char* orow = lds + (32 * w + ql) * 272;
#pragma unroll
    for (int dt = 0; dt < 4; ++dt)
#pragma unroll
        for (int g4 = 0; g4 < 4; ++g4) {
            u32x2 o; o[0] = pk2(O[dt][4 * g4] * inv, O[dt][4 * g4 + 1] * inv); o[1] = pk2(O[dt][4 * g4 + 2] * inv, O[dt][4 * g4 + 3] * inv);
            *(LAS u32x2*)(orow + (32 * dt + 8 * g4 + 4 * h) * 2) = o;
        }
#pragma unroll
    for (int i = 0; i < 8; ++i) {
        const int id = lane + 64 * i, r = 32 * w + (id >> 4), cc = id & 15;
        const u32x4 ov = *(const LAS u32x4*)(lds + r * 272 + cc * 16);
        const u32x4 gz = *(const u32x4*)(gate + (size_t)r * ldg + cc * 8);
        u32x4 res;
#pragma unroll
        for (int e = 0; e < 4; ++e) res[e] = pk2(bflo(ov[e]) * silu(bflo(gz[e])), bfhi(ov[e]) * silu(bfhi(gz[e])));
        *(u32x4*)(out + (size_t)r * ldo + cc * 8) = res;
    }
    __syncthreads();
}

DI void mem_item(const Ctx& c, int it, const bf16_t* proj, int ldp, int col_mq, int col_mz, const bf16_t* memK, const bf16_t* memVT, bf16_t* mix) {
    const int qb = it & 15, mh = (it >> 4) & 3, b = it >> 6;
    const size_t row0 = (size_t)b * SEQ + 256 * qb;
    flash_item<128, false>(c.lds, proj + row0 * ldp + col_mq + mh * 128, ldp, memK + (size_t)(b * 256) * 512 + mh * 128, 512,
                           memVT + (size_t)(mh * 128) * 1024 + b * 256, 1024, 256, 0, proj + row0 * ldp + col_mz + mh * 128, ldp, mix + row0 * 2048 + 1536 + mh * 128, 2048);
}

DI float log_sigmoid(float x) { return fminf(x, 0.f) - __logf(1.f + __expf(-fabsf(x))); }
constexpr int GL_G = 0;
constexpr int GL_RED = 4096;
constexpr int GL_TOT = 5120;
constexpr int GL_Q = 12288;
constexpr int GL_K = GL_Q + 25600;
constexpr int GL_KT = GL_K + 25600;
constexpr int GL_O = GL_K + 25600;
DI void gla_prep(const Ctx& c, const bf16_t* projA, size_t tok0, int hh, float* dv, const int tid) {
    LAS float* sg = (LAS float*)(c.lds + GL_G);
#pragma unroll
    for (int i = 0; i < 2; ++i) { const int id = tid + NTHR * i, t = id >> 4, r = id & 15; sg[id] = bf2f(projA[(tok0 + t) * NA + A_G + r]); }
#pragma unroll
    for (int i = 0; i < 3; ++i) { const int id = tid + NTHR * i, r = id / 24, cc = id % 24;
        *(LAS u32x4*)(c.lds + GL_K + r * 400 + cc * 16) = *(const u32x4*)(projA + (tok0 + r) * NA + A_K + hh * 192 + cc * 8);
        *(LAS u32x4*)(c.lds + GL_Q + r * 400 + cc * 16) = *(const u32x4*)(projA + (tok0 + r) * NA + A_Q + hh * 192 + cc * 8); }
    const int tg = tid >> 6, lane = tid & 63;
    const float* wg2 = c.in(5) + hh * 192 + lane; const float* bg = c.in(6) + hh * 192 + lane;
    float wg[3][16], bias[3];
#pragma unroll
    for (int ci = 0; ci < 3; ++ci) { bias[ci] = bg[64 * ci];
#pragma unroll
        for (int r = 0; r < 16; ++r) wg[ci][r] = wg2[r * 768 + 64 * ci]; }
    __syncthreads();
    float cl[3][8]; float run[3] = {0.f, 0.f, 0.f};
    LAS float* tot = (LAS float*)(c.lds + GL_TOT);
#pragma unroll
    for (int i = 0; i < 8; ++i) {
        const int t = 8 * tg + i;
        f32x4 g4[4];
#pragma unroll
        for (int r4 = 0; r4 < 4; ++r4) g4[r4] = *(const LAS f32x4*)(sg + t * 16 + 4 * r4);
#pragma unroll
        for (int ci = 0; ci < 3; ++ci) {
            float x = bias[ci];
#pragma unroll
            for (int r4 = 0; r4 < 4; ++r4) x += g4[r4][0] * wg[ci][4 * r4] + g4[r4][1] * wg[ci][4 * r4 + 1] + g4[r4][2] * wg[ci][4 * r4 + 2] + g4[r4][3] * wg[ci][4 * r4 + 3];
            run[ci] += log_sigmoid(x) * (1.f / 16.f); cl[ci][i] = run[ci];
        }
    }
#pragma unroll
    for (int ci = 0; ci < 3; ++ci) tot[tg * 192 + lane + 64 * ci] = run[ci];
    __syncthreads();
#pragma unroll
    for (int ci = 0; ci < 3; ++ci) {
        const int j = lane + 64 * ci;
        float off = 0.f, last = 0.f;
#pragma unroll
        for (int g = 0; g < 8; ++g) { const float tv = tot[g * 192 + j]; last += tv; if (g < tg) off += tv; }
        if (tg == 0) dv[j] = __expf(last);
        float kh[8];
#pragma unroll
        for (int i = 0; i < 8; ++i) {
            const int t = 8 * tg + i; const float cum = cl[ci][i] + off;
            LAS bf16_t* qp = (LAS bf16_t*)(c.lds + GL_Q + t * 400 + j * 2); LAS bf16_t* kp = (LAS bf16_t*)(c.lds + GL_K + t * 400 + j * 2);
            const float kv = bf2f(*kp);
            *qp = f2bf(bf2f(*qp) * __expf(cum)); *kp = f2bf(kv * __expf(-cum));
            kh[i] = kv * __expf(last - cum);
        }
        const int blk = (tg >> 1) * 16, p0 = tokperm16((tg & 1) * 8), p1 = tokperm16((tg & 1) * 8 + 4);
        u32x2 w0, w1; w0[0] = pk2(kh[0], kh[1]); w0[1] = pk2(kh[2], kh[3]); w1[0] = pk2(kh[4], kh[5]); w1[1] = pk2(kh[6], kh[7]);
        *(LAS u32x2*)(c.lds + GL_KT + j * 144 + (blk + p0) * 2) = w0;
        *(LAS u32x2*)(c.lds + GL_KT + j * 144 + (blk + p1) * 2) = w1;
    }
    __syncthreads();
}
DI void gla_local_item(const Ctx& c, int item) {
    const int hh = item & 3, ch = (item >> 2) & 63, b = item >> 8;
    const size_t tok0 = (size_t)b * SEQ + 64 * ch;
    const bf16_t* projA = (const bf16_t*)(c.ws + O_PROJ);
    const bf16_t* vT = (const bf16_t*)(c.ws + O_VT);
    bf16_t* st = (bf16_t*)(c.ws + O_ST) + (size_t)item * 73728;
    float* dv = (float*)(c.ws + O_DVEC) + (size_t)item * 192;
    int tid = threadIdx.x; asm volatile("" : "+v"(tid));
    const int w = __builtin_amdgcn_readfirstlane(tid >> 6), lane = tid & 63, ql = lane & 31, h = lane >> 5;
    const int jg = w & 1, vg = w >> 1;
    bf16x8 vf[3][4];
#pragma unroll
    for (int vt = 0; vt < 3; ++vt)
#pragma unroll
        for (int ks = 0; ks < 4; ++ks) vf[vt][ks] = *(const bf16x8*)(vT + ((((size_t)(hh * 12 + 3 * vg + vt) * (T / 64) + (tok0 >> 6)) * 4 + ks) * 64 + lane) * 8);
    gla_prep(c, projA, tok0, hh, dv, tid);
    bf16_t* projW = (bf16_t*)(c.ws + O_PROJ);
#pragma unroll
    for (int i = 0; i < 3; ++i) { const int id = tid + NTHR * i, r = id / 24, cc = id % 24;
        *(u32x4*)(projW + (tok0 + r) * NA + A_K + hh * 192 + cc * 8) = *(const LAS u32x4*)(c.lds + GL_K + r * 400 + cc * 16);
        *(u32x4*)(projW + (tok0 + r) * NA + A_Q + hh * 192 + cc * 8) = *(const LAS u32x4*)(c.lds + GL_Q + r * 400 + cc * 16); }
    f32x16 U[3][3];
#pragma unroll
    for (int a = 0; a < 3; ++a)
#pragma unroll
        for (int bq = 0; bq < 3; ++bq)
#pragma unroll
            for (int i = 0; i < 16; ++i) U[a][bq][i] = 0.f;
#pragma unroll
    for (int ks = 0; ks < 4; ++ks)
#pragma unroll
        for (int jt = 0; jt < 3; ++jt) {
            const bf16x8 kf = *(const LAS bf16x8*)(c.lds + GL_KT + (32 * (3 * jg + jt) + ql) * 144 + (16 * ks + 8 * h) * 2);
#pragma unroll
            for (int vt = 0; vt < 3; ++vt) U[jt][vt] = MFMA32(kf, vf[vt][ks], U[jt][vt]);
        }
#pragma unroll
    for (int jt = 0; jt < 3; ++jt)
#pragma unroll
        for (int vt = 0; vt < 3; ++vt)
#pragma unroll
            for (int g4 = 0; g4 < 4; ++g4) {
                const int ks = 2 * (3 * jg + jt) + (g4 >> 1);
                u32x2 o; o[0] = pk2(U[jt][vt][4 * g4], U[jt][vt][4 * g4 + 1]); o[1] = pk2(U[jt][vt][4 * g4 + 2], U[jt][vt][4 * g4 + 3]);
                *(u32x2*)(st + (size_t)(((3 * vg + vt) * 12 + ks) * 64 + ql + 32 * (g4 & 1)) * 8 + 4 * h) = o;
            }
    __syncthreads();
}
template <int GD> struct ScanGrp { u32x4 u[GD]; f32x4 d0[GD], d1[GD]; };
template <int GD> DI void scan_load(ScanGrp<GD>& g, const bf16_t* stb, const float* dvb, int b, int hh, int e, int j0, int ch0) {
#pragma unroll
    for (int i = 0; i < GD; ++i) { const size_t item = (size_t)(b * 64 + ch0 + i) * 4 + hh;
        g.u[i] = ldnt_u4(stb + item * 73728 + (size_t)e * 8); g.d0[i] = *(const f32x4*)(dvb + item * 192 + j0); g.d1[i] = *(const f32x4*)(dvb + item * 192 + j0 + 4); }
}
template <int GD> DI void scan_apply(const ScanGrp<GD>& g, float (&s)[8], bf16_t* stb, int b, int hh, int e, int ch0) {
#pragma unroll
    for (int i = 0; i < GD; ++i) { const size_t item = (size_t)(b * 64 + ch0 + i) * 4 + hh;
        u32x4 o; o[0] = pk2(s[0], s[1]); o[1] = pk2(s[2], s[3]); o[2] = pk2(s[4], s[5]); o[3] = pk2(s[6], s[7]);
        *(u32x4*)(stb + item * 73728 + (size_t)e * 8) = o;
        const u32x4 u = g.u[i]; const f32x4 d0 = g.d0[i], d1 = g.d1[i];
        s[0] = d0[0] * s[0] + bflo(u[0]); s[1] = d0[1] * s[1] + bfhi(u[0]); s[2] = d0[2] * s[2] + bflo(u[1]); s[3] = d0[3] * s[3] + bfhi(u[1]);
        s[4] = d1[0] * s[4] + bflo(u[2]); s[5] = d1[1] * s[5] + bfhi(u[2]); s[6] = d1[2] * s[6] + bflo(u[3]); s[7] = d1[3] * s[7] + bfhi(u[3]); }
}
template <int NEL, int GD>
DI void gla_scan_thread(bf16_t* stb, const float* dvb, int idx0, int stride) {
    int b[NEL], hh[NEL], e[NEL], j0[NEL]; float s[NEL][8]; ScanGrp<GD> ga[NEL], gb[NEL];
#pragma unroll
    for (int k = 0; k < NEL; ++k) { const int idx = idx0 + k * stride, bh = idx / 9216; e[k] = idx % 9216; b[k] = bh >> 2; hh[k] = bh & 3; j0[k] = 16 * ((e[k] >> 6) % 12) + 8 * ((e[k] >> 5) & 1);
#pragma unroll
        for (int i = 0; i < 8; ++i) s[k][i] = 0.f;
        scan_load<GD>(ga[k], stb, dvb, b[k], hh[k], e[k], j0[k], 0); }
    for (int ch0 = 0; ch0 < 64; ch0 += 2 * GD) {
#pragma unroll
        for (int k = 0; k < NEL; ++k) scan_load<GD>(gb[k], stb, dvb, b[k], hh[k], e[k], j0[k], ch0 + GD);
#pragma unroll
        for (int k = 0; k < NEL; ++k) scan_apply<GD>(ga[k], s[k], stb, b[k], hh[k], e[k], ch0);
        if (ch0 + 2 * GD < 64) {
#pragma unroll
            for (int k = 0; k < NEL; ++k) scan_load<GD>(ga[k], stb, dvb, b[k], hh[k], e[k], j0[k], ch0 + 2 * GD);
        }
#pragma unroll
        for (int k = 0; k < NEL; ++k) scan_apply<GD>(gb[k], s[k], stb, b[k], hh[k], e[k], ch0 + GD);
    }
}
DI void gla_scan(const Ctx& c) {
    bf16_t* stb = (bf16_t*)(c.ws + O_ST); const float* dvb = (const float*)(c.ws + O_DVEC);
    const int total = 16 * 9216, per = (total + (int)gridDim.x - 1) / (int)gridDim.x;
    const int lo = blockIdx.x * per, hi = (lo + per < total) ? lo + per : total;
    for (int base = lo; base < hi; base += 2 * NTHR) {
        const int i0 = base + threadIdx.x, i1 = i0 + NTHR;
        if (i1 < hi) gla_scan_thread<2, 2>(stb, dvb, i0, NTHR);
        else if (i0 < hi) gla_scan_thread<1, 4>(stb, dvb, i0, 0);
    }
}
struct GlaPre { u32x4 kq[6]; bf16x8 sfA[12]; };
DI void gla_out_prefetch(const Ctx& c, int item, int tid, GlaPre& P) {
    const int hh = item & 3, ch = (item >> 2) & 63, b = item >> 8;
    const size_t tok0 = (size_t)b * SEQ + 64 * ch;
    const bf16_t* projA = (const bf16_t*)(c.ws + O_PROJ);
    const bf16_t* st = (const bf16_t*)(c.ws + O_ST) + (size_t)item * 73728;
    const int w = __builtin_amdgcn_readfirstlane(tid >> 6), lane = tid & 63, ql = lane & 31, h = lane >> 5, vg = w >> 1;
#pragma unroll
    for (int ks = 0; ks < 12; ++ks) P.sfA[ks] = __builtin_nontemporal_load((const bf16x8*)(st + (size_t)(((3 * vg) * 12 + ks) * 64 + lane) * 8));
#pragma unroll
    for (int i = 0; i < 3; ++i) { const int id = tid + NTHR * i, r = id / 24, cc = id % 24;
        P.kq[2 * i] = *(const u32x4*)(projA + (tok0 + r) * NA + A_K + hh * 192 + cc * 8);
        P.kq[2 * i + 1] = *(const u32x4*)(projA + (tok0 + r) * NA + A_Q + hh * 192 + cc * 8); }
}
DI void gla_out_phase(const Ctx& c) {
  GlaPre P;
  if ((int)blockIdx.x < 1024) gla_out_prefetch(c, blockIdx.x, threadIdx.x, P);
  for (int item = blockIdx.x; item < 1024; item += gridDim.x) {
    const int hh = item & 3, ch = (item >> 2) & 63, b = item >> 8;
    const size_t tok0 = (size_t)b * SEQ + 64 * ch;
    const bf16_t* projA = (const bf16_t*)(c.ws + O_PROJ);
    const bf16_t* vT = (const bf16_t*)(c.ws + O_VT);
    const bf16_t* st = (const bf16_t*)(c.ws + O_ST) + (size_t)item * 73728;
    bf16_t* mix = (bf16_t*)(c.ws + O_H);
    int tid = threadIdx.x; asm volatile("" : "+v"(tid));
    const int w = __builtin_amdgcn_readfirstlane(tid >> 6), lane = tid & 63, ql = lane & 31, h = lane >> 5;
    const int tt = w & 1, vg = w >> 1;
    bf16x8 sfB[12];
#pragma unroll
    for (int i = 0; i < 3; ++i) { const int id = tid + NTHR * i, r = id / 24, cc = id % 24;
        *(LAS u32x4*)(c.lds + GL_K + r * 400 + cc * 16) = P.kq[2 * i];
        *(LAS u32x4*)(c.lds + GL_Q + r * 400 + cc * 16) = P.kq[2 * i + 1]; }
    __syncthreads();
    bf16x8 qf[12];
#pragma unroll
    for (int ks = 0; ks < 12; ++ks) qf[ks] = *(const LAS bf16x8*)(c.lds + GL_Q + (32 * tt + ql) * 400 + (16 * ks + 8 * h) * 2);
    bf16x8 pf[4];
#pragma unroll
    for (int stl = 0; stl < 2; ++stl) {
        f32x16 Sx;
#pragma unroll
        for (int i = 0; i < 16; ++i) Sx[i] = 0.f;
        if (stl <= tt) {
#pragma unroll
            for (int ks = 0; ks < 12; ++ks) {
                const bf16x8 kf = *(const LAS bf16x8*)(c.lds + GL_K + (32 * stl + ql) * 400 + (16 * ks + 8 * h) * 2);
                Sx = MFMA32(kf, qf[ks], Sx);
            }
            if (stl == tt) {
#pragma unroll
                for (int i = 0; i < 16; ++i) { const int s = 8 * (i >> 2) + 4 * h + (i & 3); if (s > ql) Sx[i] = 0.f; }
            }
        }
#pragma unroll
        for (int bq = 0; bq < 2; ++bq) { const int e0 = 8 * bq;
            u32x4 pw; pw[0] = pk2(Sx[e0], Sx[e0 + 1]); pw[1] = pk2(Sx[e0 + 2], Sx[e0 + 3]); pw[2] = pk2(Sx[e0 + 4], Sx[e0 + 5]); pw[3] = pk2(Sx[e0 + 6], Sx[e0 + 7]);
            pf[2 * stl + bq] = __builtin_bit_cast(bf16x8, pw); }
    }
    __builtin_amdgcn_sched_barrier(0);
#pragma unroll
    for (int ks = 0; ks < 12; ++ks) sfB[ks] = __builtin_nontemporal_load((const bf16x8*)(st + (size_t)(((3 * vg + 1) * 12 + ks) * 64 + lane) * 8));
    float ssq = 0.f;
#pragma unroll
    for (int vt = 0; vt < 3; ++vt) {
        const int v = 32 * (3 * vg + vt) + ql;
        bf16x8 vf[4];
#pragma unroll
        for (int bq = 0; bq < 4; ++bq) vf[bq] = *(const bf16x8*)(vT + ((((size_t)(hh * 12 + 3 * vg + vt) * (T / 64) + (tok0 >> 6)) * 4 + bq) * 64 + lane) * 8);
        f32x16 Oa;
#pragma unroll
        for (int i = 0; i < 16; ++i) Oa[i] = 0.f;
#pragma unroll
        for (int ks = 0; ks < 12; ++ks) Oa = MFMA32((vt == 1 ? sfB[ks] : P.sfA[ks]), qf[ks], Oa);
        if (vt == 0) {
#pragma unroll
            for (int ks = 0; ks < 12; ++ks) P.sfA[ks] = __builtin_nontemporal_load((const bf16x8*)(st + (size_t)(((3 * vg + 2) * 12 + ks) * 64 + lane) * 8));
        }
#pragma unroll
        for (int bq = 0; bq < 4; ++bq) if ((bq >> 1) <= tt) Oa = MFMA32(vf[bq], pf[bq], Oa);
#pragma unroll
        for (int i = 0; i < 16; ++i) ssq += Oa[i] * Oa[i];
#pragma unroll
        for (int g4 = 0; g4 < 4; ++g4) { u32x2 o; o[0] = pk2(Oa[4 * g4], Oa[4 * g4 + 1]); o[1] = pk2(Oa[4 * g4 + 2], Oa[4 * g4 + 3]);
            *(LAS u32x2*)(c.lds + GL_O + (32 * tt + ql) * 784 + (32 * (3 * vg + vt) + 8 * g4 + 4 * h) * 2) = o; }
    }
    if (item + (int)gridDim.x < 1024) gla_out_prefetch(c, item + gridDim.x, tid, P);
    ssq += __shfl_xor(ssq, 32, 64);
    LAS float* red = (LAS float*)(c.lds + GL_RED);
    if (h == 0) red[vg * 64 + 32 * tt + ql] = ssq;
    __syncthreads();
    const float* gg = c.in(7);
#pragma unroll
    for (int i = 0; i < 6; ++i) {
        const int id = tid + NTHR * i, t = id / 48, v0 = (id % 48) * 8;
        const float tot = red[t] + red[64 + t] + red[128 + t] + red[192 + t];
        const float rr = rsqrtf(tot * (1.f / 384.f) + EPS);
        const size_t tok = tok0 + t;
        const u32x4 o8 = *(const LAS u32x4*)(c.lds + GL_O + t * 784 + v0 * 2);
        const u32x4 z8 = ldnt_u4(projA + tok * NA + A_Z + hh * 384 + v0);
        const f32x4 g0 = *(const f32x4*)(gg + v0), g1 = *(const f32x4*)(gg + v0 + 4);
        u32x4 r;
        r[0] = pk2(bflo(o8[0]) * rr * g0[0] * silu(bflo(z8[0])), bfhi(o8[0]) * rr * g0[1] * silu(bfhi(z8[0])));
        r[1] = pk2(bflo(o8[1]) * rr * g0[2] * silu(bflo(z8[1])), bfhi(o8[1]) * rr * g0[3] * silu(bfhi(z8[1])));
        r[2] = pk2(bflo(o8[2]) * rr * g1[0] * silu(bflo(z8[2])), bfhi(o8[2]) * rr * g1[1] * silu(bfhi(z8[2])));
        r[3] = pk2(bflo(o8[3]) * rr * g1[2] * silu(bflo(z8[3])), bfhi(o8[3]) * rr * g1[3] * silu(bfhi(z8[3])));
        *(u32x4*)(mix + tok * 2048 + hh * 384 + v0) = r;
    }
    __syncthreads();
  }
}

template <bool WITH_H>
DI void post_rows(const float* xin, const bf16_t* y, const float* g, float* xo, bf16_t* hn) {
    const int lane = threadIdx.x & 63, wv = threadIdx.x >> 6;
    f32x4 gv[8];
#pragma unroll
    for (int k = 0; k < 8; ++k) gv[k] = *(const f32x4*)(g + 4 * lane + 256 * k);
    for (int r0 = (blockIdx.x * 8 + wv) * 2; r0 < T; r0 += gridDim.x * 16) {
        u32x2 yu[2][8]; f32x4 xv[2][8];
#pragma unroll
        for (int rr = 0; rr < 2; ++rr)
#pragma unroll
            for (int k = 0; k < 8; ++k) {
                yu[rr][k] = ldnt_u2(y + (size_t)(r0 + rr) * 2048 + 4 * lane + 256 * k);
                xv[rr][k] = ldnt_f4(xin + (size_t)(r0 + rr) * 2048 + 4 * lane + 256 * k);
            }
#pragma unroll
        for (int rr = 0; rr < 2; ++rr) {
            const int r = r0 + rr;
            f32x4 yv[8]; float ss = 0.f;
#pragma unroll
            for (int k = 0; k < 8; ++k) { yv[k] = (f32x4){bflo(yu[rr][k][0]), bfhi(yu[rr][k][0]), bflo(yu[rr][k][1]), bfhi(yu[rr][k][1])};
                ss += yv[k][0] * yv[k][0] + yv[k][1] * yv[k][1] + yv[k][2] * yv[k][2] + yv[k][3] * yv[k][3]; }
            ss = wave_sum(ss); const float rs = rsqrtf(ss * (1.f / 2048.f) + EPS);
            float s1 = 0.f;
#pragma unroll
            for (int k = 0; k < 8; ++k) {
                const f32x4 o = xv[rr][k] + yv[k] * rs * gv[k];
                s1 += o[0] * o[0] + o[1] * o[1] + o[2] * o[2] + o[3] * o[3];
                yv[k] = o;
                stnt_f4(xo + (size_t)r * 2048 + 4 * lane + 256 * k, o);
            }
            if (WITH_H) {
                s1 = wave_sum(s1); const float r1 = rsqrtf(s1 * (1.f / 2048.f) + EPS);
#pragma unroll
                for (int k = 0; k < 8; ++k) { u32x2 w2; w2[0] = pk2(yv[k][0] * r1, yv[k][1] * r1); w2[1] = pk2(yv[k][2] * r1, yv[k][3] * r1);
                    *(u32x2*)(hn + (size_t)r * 2048 + 4 * lane + 256 * k) = w2; }
            }
        }
    }
}
DI void phase6(const Ctx& c) {
    const bf16_t* projB = (const bf16_t*)(c.ws + O_PROJ);
    bf16_t* cn = (bf16_t*)(c.ws + O_CN); bf16_t* cqn = (bf16_t*)(c.ws + O_CQN); bf16_t* kf = (bf16_t*)(c.ws + O_KF);
    float* cosT = (float*)(c.ws + O_COS); float* sinT = (float*)(c.ws + O_SIN);
    const int* pos = (const int*)c.in(2);
    const int lane = threadIdx.x & 63, wv = threadIdx.x >> 6;
    for (int r0 = (blockIdx.x * 8 + wv) * 2; r0 < T; r0 += gridDim.x * 16) {
        u32x4 uc[2], uq[2];
#pragma unroll
        for (int rr = 0; rr < 2; ++rr) { const bf16_t* pr = projB + (size_t)(r0 + rr) * NBI; uc[rr] = *(const u32x4*)(pr + B_C + 8 * lane); uq[rr] = *(const u32x4*)(pr + B_CQ + 8 * lane); }
        const int rme = r0 + (lane >> 5), i = lane & 31;
        const bf16_t* prm = projB + (size_t)rme * NBI;
        const float x1 = bf2f(prm[B_KR + i]), x2 = bf2f(prm[B_KR + 32 + i]);
        const float pz = (float)pos[rme];
#pragma unroll
        for (int rr = 0; rr < 2; ++rr) {
            const int r = r0 + rr;
            float cv[8], qv[8]; float sc = 0.f, sq = 0.f;
#pragma unroll
            for (int e = 0; e < 4; ++e) { cv[2 * e] = bflo(uc[rr][e]); cv[2 * e + 1] = bfhi(uc[rr][e]); qv[2 * e] = bflo(uq[rr][e]); qv[2 * e + 1] = bfhi(uq[rr][e]); }
#pragma unroll
            for (int e = 0; e < 8; ++e) { sc += cv[e] * cv[e]; sq += qv[e] * qv[e]; }
            sc = wave_sum(sc); sq = wave_sum(sq);
            const float rc = rsqrtf(sc * (1.f / 512.f) + EPS), rq = rsqrtf(sq * (1.f / 512.f) + EPS);
            u32x4 oc, oq;
#pragma unroll
            for (int e = 0; e < 4; ++e) { oc[e] = pk2(cv[2 * e] * rc, cv[2 * e + 1] * rc); oq[e] = pk2(qv[2 * e] * rq, qv[2 * e + 1] * rq); }
            *(u32x4*)(cn + (size_t)r * 512 + 8 * lane) = oc; *(u32x4*)(cqn + (size_t)r * 512 + 8 * lane) = oq;
        }
        {
            const float freq = exp2f(-(float)i * (13.287712379549449f / 32.f));
            float sn, cs; sincosf(pz * freq, &sn, &cs);
            cosT[(size_t)rme * 32 + i] = cs; sinT[(size_t)rme * 32 + i] = sn;
            const float o1 = x1 * cs - x2 * sn, o2 = x2 * cs + x1 * sn;
            const float a1 = __shfl_down(o1, 1, 64), a2 = __shfl_down(o1, 2, 64), a3 = __shfl_down(o1, 3, 64);
            const float b1 = __shfl_down(o2, 1, 64), b2 = __shfl_down(o2, 2, 64), b3 = __shfl_down(o2, 3, 64);
            if ((i & 3) == 0) {
                u32x4 w; w[0] = pk2(o1, a1); w[1] = pk2(a2, a3); w[2] = pk2(o2, b1); w[3] = pk2(b2, b3);
#pragma unroll
                for (int hd = 0; hd < 12; ++hd) *(u32x4*)(kf + (size_t)rme * 2304 + hd * 192 + 128 + 2 * i) = w;
            }
        }
    }
}

#define XB_TMO      128
#define XB_XCNT(j)  (256  + 64 * (j))
#define XB_XSUB(j)  (1280 + 64 * (j))
#define XB_XGEN(j)  (2304 + 64 * (j))
#define XB_TOP      3328
#define XB_TOPGEN   3392
#define XCD_BAR_WORDS 3456
#define XB_SPIN_CAP (1u << 18)

__device__ __forceinline__ unsigned xb_ld(unsigned* p)              { return __hip_atomic_load(p, __ATOMIC_RELAXED, __HIP_MEMORY_SCOPE_AGENT); }
__device__ __forceinline__ unsigned xb_add(unsigned* p, unsigned v) { return __hip_atomic_fetch_add(p, v, __ATOMIC_RELAXED, __HIP_MEMORY_SCOPE_AGENT); }
__device__ __forceinline__ unsigned xb_xcc_id() { return (unsigned)__builtin_amdgcn_s_getreg((3 << 11) | 20) & 0xFu; }
#define XB_SPIN(cond, bar) do { unsigned _sp = 0; while (cond) { __builtin_amdgcn_s_sleep(1); \
    if ((++_sp & 255u) == 0u) { if (xb_ld(&(bar)[XB_TMO])) break; if (_sp > XB_SPIN_CAP) { atomicAdd(&(bar)[XB_TMO], 1u); break; } } } } while (0)

struct XcdBarrier {
    unsigned* bar; unsigned x;
    volatile LAS unsigned* st;
};

__device__ __forceinline__ XcdBarrier xcd_barrier_post(unsigned* bar, volatile LAS unsigned* st) {
    XcdBarrier b; b.bar = bar; b.x = xb_xcc_id(); b.st = st;
    if (threadIdx.x == 0) (void)xb_add(&bar[XB_XCNT(b.x)], 1u);
    return b;
}
__device__ __forceinline__ void xcd_barrier_complete(unsigned* bar, unsigned x, unsigned& nloc, unsigned& nx) {
    const unsigned G = gridDim.x * gridDim.y * gridDim.z;
    unsigned sum, cnt, mine, sp = 0u;
    for (;;) {
        sum = 0u; cnt = 0u; mine = 0u;
#pragma unroll
        for (unsigned j = 0; j < 16; ++j) { const unsigned c = xb_ld(&bar[XB_XCNT(j)]); sum += c; cnt += (c > 0u) ? 1u : 0u; mine = (j == x) ? c : mine; }
        if (sum == G) break;
        __builtin_amdgcn_s_sleep(1);
        if ((++sp & 255u) == 0u) { if (xb_ld(&bar[XB_TMO])) break; if (sp > XB_SPIN_CAP) { atomicAdd(&bar[XB_TMO], 1u); break; } }
    }
    nloc = mine > 0u ? mine : 1u; nx = cnt > 0u ? cnt : 1u;
}

__device__ __forceinline__ void xcd_barrier(const XcdBarrier& b) {
    asm volatile("s_waitcnt vmcnt(0)" ::: "memory");
    __syncthreads();
    if (threadIdx.x == 0) {
        unsigned* bar = b.bar;
        __builtin_amdgcn_s_waitcnt(0);
        unsigned nloc = b.st[0], nx = b.st[1];
        if (nloc == 0u) { xcd_barrier_complete(bar, b.x, nloc, nx); b.st[0] = nloc; b.st[1] = nx; }
        const unsigned old = xb_add(&bar[XB_XSUB(b.x)], 1u);
        const unsigned gen = old / nloc;
        if (old + 1u == (gen + 1u) * nloc) {
            __builtin_amdgcn_fence(__ATOMIC_RELEASE, "agent");
            asm volatile("s_waitcnt vmcnt(0)" ::: "memory");
            const unsigned og = xb_add(&bar[XB_TOP], 1u);
            const unsigned tg = og / nx;
            if (og + 1u == (tg + 1u) * nx) xb_add(&bar[XB_TOPGEN], 1u);
            else XB_SPIN(xb_ld(&bar[XB_TOPGEN]) == tg, bar);
            __builtin_amdgcn_fence(__ATOMIC_ACQUIRE, "agent");
            xb_add(&bar[XB_XGEN(b.x)], 1u);
            asm volatile("s_waitcnt vmcnt(0)" ::: "memory");
        } else {
            XB_SPIN(xb_ld(&bar[XB_XGEN(b.x)]) == gen, bar);
            __builtin_amdgcn_fence(__ATOMIC_ACQUIRE, "agent");
            asm volatile("s_waitcnt vmcnt(0)" ::: "memory");
        }
    }
    __syncthreads();
}


constexpr int LDS_CTL = 131072;
constexpr int LDS_BYTES = 131072 + 64;
struct Args { const float* in[25]; float* out; unsigned char* ws; int ph_lo, ph_hi; };

__global__ void __launch_bounds__(NTHR, 2) yoco_fwd(Args a) {
    extern __shared__ __attribute__((aligned(16))) unsigned char lds_raw[];
    cg::grid_group grid = cg::this_grid();
    Ctx c;
    c.ka = (kargp_t)__builtin_amdgcn_kernarg_segment_ptr();
    c.out = a.out; c.ws = a.ws; c.lds = (LAS unsigned char*)lds_raw;
    const int lo = a.ph_lo, hi = a.ph_hi;
    volatile LAS unsigned* xbst = (volatile LAS unsigned*)(c.lds + LDS_CTL);
    if (threadIdx.x < 4) xbst[threadIdx.x] = 0u;
    __syncthreads();
    XcdBarrier xbar = xcd_barrier_post((unsigned*)(c.ws + O_CTL) + 64, xbst);
    const float* cosT = (const float*)(c.ws + O_COS); const float* sinT = (const float*)(c.ws + O_SIN);
#define IN(k) (lo <= (k) && (k) < hi)
#ifndef DBLMASK
#define DBLMASK 0
#endif
#define REPS(k) for (int rep_ = 0; rep_ < (((DBLMASK >> (k)) & 1) ? 2 : 1); ++rep_)
#define SEAM(k) do { if (IN(k) && IN((k) + 1)) xcd_barrier(xbar); } while (0)
    if (hi == 9999) grid.sync();
    if (IN(0)) REPS(0) phase0(c);
    SEAM(0);
    if (IN(1)) { pg8::gemm_phase<1>(c.lds, c.ws, cosT, sinT); conv_fill(c, 1504, 2, 2); }
    SEAM(1);
    if (IN(2)) {
        for (int s = 0; s < 2; ++s) {
            if (((s ^ (int)blockIdx.x) & 1) == 0) { for (int it = blockIdx.x; it < 1024; it += gridDim.x) gla_local_item(c, it); }
            else { for (int it = blockIdx.x; it < 256; it += gridDim.x)
                mem_item(c, it, (const bf16_t*)(c.ws + O_PROJ), NA, A_MQ, A_MZ, (const bf16_t*)(c.ws + O_MEMK_A), (const bf16_t*)(c.ws + O_MEMVT_A), (bf16_t*)(c.ws + O_H)); }
        }
    }
    SEAM(2);
    if (IN(3)) gla_scan(c);
    SEAM(3);
    if (IN(4)) gla_out_phase(c);
    SEAM(4);
    if (IN(5)) REPS(5) pg8::gemm_phase<3>(c.lds, c.ws, cosT, sinT);
    SEAM(5);
    if (IN(6)) REPS(6) post_rows<true>(c.in(0), (const bf16_t*)(c.ws + O_PROJ), c.in(11), c.out, (bf16_t*)(c.ws + O_H));
    SEAM(6);
    if (IN(7)) { pg8::gemm_phase<5>(c.lds, c.ws, cosT, sinT); conv_fill(c, 960, 8, 11); }
    SEAM(7);
    if (IN(8)) REPS(8) phase6(c);
    SEAM(8);
    if (IN(9)) REPS(9) pg8::gemm_phase<7>(c.lds, c.ws, cosT, sinT);
    SEAM(9);
    if (IN(10)) REPS(10) {
        unsigned* ctr = (unsigned*)(c.ws + O_CTL) + rep_;
        LAS unsigned* sh = (LAS unsigned*)(c.lds + LDS_CTL + 16);
        const bf16_t* Qb = (const bf16_t*)(c.ws + O_Q); const bf16_t* Kf = (const bf16_t*)(c.ws + O_KF); const bf16_t* VT = (const bf16_t*)(c.ws + O_VT);
        const bf16_t* projB = (const bf16_t*)(c.ws + O_PROJ); bf16_t* mix = (bf16_t*)(c.ws + O_H);
        for (;;) {
            if (threadIdx.x == 0) *sh = atomicAdd(ctr, 1u);
            __syncthreads();
            const unsigned it = (unsigned)__builtin_amdgcn_readfirstlane((int)*sh);
            __syncthreads();
            if (it >= 768u + 256u) break;
            if (it < 768u) {
                const int qb = 15 - (int)(it / 48u), bh = (int)(it % 48u), b = bh / 12, hd = bh % 12;
                const size_t row0 = (size_t)b * SEQ + 256 * qb;
                flash_item<192, true>(c.lds, Qb + row0 * 2304 + hd * 192, 2304, Kf + (size_t)b * SEQ * 2304 + hd * 192, 2304,
                                      VT + (size_t)(hd * 128) * T + (size_t)b * SEQ, T, 256 * (qb + 1), 256 * qb,
                                      projB + row0 * NBI + B_Z + hd * 128, NBI, mix + row0 * 2048 + hd * 128, 2048);
            } else {
                mem_item(c, (int)it - 768, projB, NBI, B_MQ, B_MZ, (const bf16_t*)(c.ws + O_MEMK_B), (const bf16_t*)(c.ws + O_MEMVT_B), mix);
            }
        }
    }
    SEAM(10);
    if (IN(11)) REPS(11) pg8::gemm_phase<9>(c.lds, c.ws, cosT, sinT);
    SEAM(11);
    if (IN(12)) post_rows<false>(c.out, (const bf16_t*)(c.ws + O_ST), c.in(24), c.out, nullptr);
#ifndef GEMM_PROBE
#define GEMM_PROBE 0
#endif
    if (GEMM_PROBE && hi == 13) {
        xcd_barrier(xbar);
        if (GEMM_PROBE & 1) pg8::gemm_phase<1>(c.lds, c.ws, cosT, sinT);
        if (GEMM_PROBE & 2) pg8::gemm_phase<3>(c.lds, c.ws, cosT, sinT);
        if (GEMM_PROBE & 4) pg8::gemm_phase<5>(c.lds, c.ws, cosT, sinT);
        if (GEMM_PROBE & 8) pg8::gemm_phase<7>(c.lds, c.ws, cosT, sinT);
        if (GEMM_PROBE & 16) pg8::gemm_phase<9>(c.lds, c.ws, cosT, sinT);
        if (GEMM_PROBE & 32) gla_scan(c);
        if (GEMM_PROBE & 64) for (int i = 0; i < 20; ++i) xcd_barrier(xbar);
    }
#undef IN
#undef SEAM
}

constexpr int N_PHASES = 13;
#ifndef MK_ONE_LAUNCH
#define MK_ONE_LAUNCH 1
#endif

extern "C" void kernel_launch(void* const* d_in, const int* in_sizes, int n_in, void* d_out, int out_size, void* d_ws, size_t ws_size, hipStream_t stream) {
    static int grid = 0;
    if (grid == 0) {
        if (ws_size < WS_END) { fprintf(stderr, "kernel_launch: workspace too small: %zu < %zu\n", ws_size, (size_t)WS_END); grid = -1; return; }
        int dev = 0, cus = 0, per_cu = 0;
        hipGetDevice(&dev);
        hipDeviceGetAttribute(&cus, hipDeviceAttributeMultiprocessorCount, dev);
        if (hipFuncSetAttribute((const void*)yoco_fwd, hipFuncAttributeMaxDynamicSharedMemorySize, LDS_BYTES) != hipSuccess) { fprintf(stderr, "kernel_launch: hipFuncSetAttribute failed\n"); grid = -1; return; }
        if (hipOccupancyMaxActiveBlocksPerMultiprocessor(&per_cu, (const void*)yoco_fwd, NTHR, LDS_BYTES) != hipSuccess || per_cu < 1) { fprintf(stderr, "kernel_launch: occupancy query gave %d\n", per_cu); per_cu = 1; }
        (void)hipGetLastError();
        grid = cus * 1;
        if (grid <= 0) grid = 256;
    }
    if (grid < 0) return;
    if (hipMemsetAsync((char*)d_ws + O_CTL, 0, CTL_BYTES, stream) != hipSuccess) { fprintf(stderr, "kernel_launch: memset failed\n"); return; }
    Args a{};
    for (int i = 0; i < 25; ++i) a.in[i] = (const float*)d_in[i];
    a.out = (float*)d_out; a.ws = (unsigned char*)d_ws;
#if MK_ONE_LAUNCH
    a.ph_lo = 0; a.ph_hi = N_PHASES;
    void* args[] = {&a};
    hipError_t e = hipLaunchCooperativeKernel((const void*)yoco_fwd, dim3(grid), dim3(NTHR), args, LDS_BYTES, stream);
    if (e != hipSuccess) fprintf(stderr, "cooperative launch failed: %s (grid %d)\n", hipGetErrorString(e), grid);
#else
    for (int p = 0; p < N_PHASES; ++p) {
        a.ph_lo = p; a.ph_hi = p + 1;
        hipLaunchKernelGGL(yoco_fwd, dim3(grid), dim3(NTHR), LDS_BYTES, stream, a);
    }
#endif
}
```
